# Optimizing an MI355X kernel written in HIP

```python
import math
import jax, jax.numpy as jnp
from jax import lax
import numpy as np


D_MODEL = 1024
BATCH = 4
SEQ = 8192
DEPTH = 2

HEAD_DIM = 64
SB_HEADS = D_MODEL // 128
DIFF_HEADS = D_MODEL // 256
DIFF_VDIM = 2 * HEAD_DIM
SB_WIDTH = SB_HEADS * HEAD_DIM
DIFF_QK_WIDTH = DIFF_HEADS * 2 * HEAD_DIM
DIFF_V_WIDTH = DIFF_HEADS * DIFF_VDIM
IN_WIDTH = 3 * SB_WIDTH + 2 * DIFF_QK_WIDTH + DIFF_V_WIDTH
N_BRANCHES = 2
D_FF = 11 * D_MODEL // 4
N_EXPERTS = 8
TOP_K = 2
D_FF_EXPERT = 7 * D_MODEL // 2
BLOCK_Q = 128
MOE_BLOCK = 512
NORM_EPS = 1e-6
N_DENSE = (DEPTH + 1) // 2
N_MOE = DEPTH // 2

kernel_name = 'hybrid_stickbreak_diffattn_moe_block'


def rms_norm(x, g):
    xf = x.astype(jnp.float32)
    y = xf * lax.rsqrt(jnp.mean(xf * xf, axis=-1, keepdims=True) + NORM_EPS)
    return (y * g.astype(jnp.float32)).astype(x.dtype)


def alibi_slopes(n_heads):
    return jnp.asarray([2.0 ** (-8.0 * (h + 1) / n_heads) for h in range(n_heads)], dtype=jnp.float32)


def stick_breaking_attention(q, k, v):
    B, S, H, d = q.shape
    nb = S // BLOCK_Q
    scale = d ** -0.5
    qb = q.reshape(B, nb, BLOCK_Q, H, d).transpose(1, 0, 3, 2, 4)
    k_pos = jnp.arange(S)

    def one_block(args):
        q_blk, blk = args
        z = jnp.einsum('bhqd,bkhd->bhqk', q_blk, k).astype(jnp.float32) * scale
        q_pos = blk * BLOCK_Q + jnp.arange(BLOCK_Q)
        causal = k_pos[None, :] < q_pos[:, None]
        log_beta = jax.nn.log_sigmoid(z)
        log_keep = jnp.where(causal, jax.nn.log_sigmoid(-z), 0.0)
        log_survive = lax.cumsum(log_keep, axis=3, reverse=True) - log_keep
        w = jnp.where(causal, jnp.exp(log_beta + log_survive), 0.0)
        return jnp.einsum('bhqk,bkhd->bqhd', w.astype(v.dtype), v)

    o = lax.map(one_block, (qb, jnp.arange(nb)))
    return o.transpose(1, 0, 2, 3, 4).reshape(B, S, H * d)


def differential_attention(q, k, v, lam, lambda_init, subln_g):
    B, S, H, _, d = q.shape
    nb = S // BLOCK_Q
    scale = d ** -0.5
    slopes = alibi_slopes(H)
    qb = q.reshape(B, nb, BLOCK_Q, H, 2, d).transpose(1, 0, 3, 4, 2, 5)
    k_pos = jnp.arange(S)

    def one_block(args):
        q_blk, blk = args
        s = jnp.einsum('bhcqd,bkhcd->bhcqk', q_blk, k).astype(jnp.float32) * scale
        q_pos = blk * BLOCK_Q + jnp.arange(BLOCK_Q)
        dist = q_pos[:, None] - k_pos[None, :]
        bias = -slopes[:, None, None] * dist.astype(jnp.float32)
        s = jnp.where(dist >= 0, s + bias[None, :, None], -jnp.inf)
        p = jax.nn.softmax(s, axis=-1)
        attn = p[:, :, 0] - lam * p[:, :, 1]
        return jnp.einsum('bhqk,bkhe->bqhe', attn.astype(v.dtype), v)

    o = lax.map(one_block, (qb, jnp.arange(nb)))
    o = o.transpose(1, 0, 2, 3, 4).reshape(B, S, H, 2 * d)
    o = rms_norm(o, subln_g) * (1.0 - lambda_init)
    return o.reshape(B, S, H * 2 * d)


def swiglu(h, w_gate_up, w_down):
    g, u = jnp.split(h @ w_gate_up, 2, axis=-1)
    return (jax.nn.silu(g) * u) @ w_down


def moe_swiglu(h, w_router, w1, w3, w2):
    B, S, D = h.shape
    n_tok = B * S
    n_assign = n_tok * TOP_K
    n_slots = -(-n_assign // MOE_BLOCK) * MOE_BLOCK + N_EXPERTS * MOE_BLOCK
    n_blocks = n_slots // MOE_BLOCK
    t = h.reshape(n_tok, D)
    logits = (t @ w_router).astype(jnp.float32)
    top_logit, top_idx = lax.top_k(logits, TOP_K)
    top_w = jax.nn.softmax(top_logit, axis=-1)
    flat_e = top_idx.reshape(-1)
    flat_tok = jnp.repeat(jnp.arange(n_tok, dtype=jnp.int32), TOP_K)
    flat_w = top_w.reshape(-1)
    order = jnp.argsort(flat_e)
    e_sorted = flat_e[order]
    counts = jnp.bincount(flat_e, length=N_EXPERTS)
    padded = (counts + MOE_BLOCK - 1) // MOE_BLOCK * MOE_BLOCK
    start = jnp.cumsum(counts) - counts
    padded_end = jnp.cumsum(padded)
    padded_start = padded_end - padded
    slot = padded_start[e_sorted] + jnp.arange(n_assign) - start[e_sorted]
    slot_tok = jnp.zeros((n_slots,), jnp.int32).at[slot].set(flat_tok[order])
    slot_w = jnp.zeros((n_slots,), jnp.float32).at[slot].set(flat_w[order])
    block_e = jnp.minimum(
        jnp.searchsorted(padded_end, jnp.arange(n_blocks) * MOE_BLOCK, side='right'),
        N_EXPERTS - 1)
    xs = t[slot_tok].reshape(n_blocks, MOE_BLOCK, D)

    def expert_block(args):
        xb, e = args
        hid = jax.nn.silu(xb @ w1[e]) * (xb @ w3[e])
        return hid @ w2[e]

    ys = lax.map(expert_block, (xs, block_e)).reshape(n_slots, D)
    ys = ys * slot_w[:, None].astype(ys.dtype)
    out = jax.ops.segment_sum(ys, slot_tok, num_segments=n_tok)
    return out.reshape(B, S, D)


def _normal(k, shape, scale):
    return jax.random.normal(k, shape, jnp.float32) * scale


def setup_inputs(seed: int = 0) -> dict:
    key = jax.random.key(seed)
    ks = jax.random.split(key, 20)
    D = D_MODEL
    return {
        'x': _normal(ks[0], (BATCH, SEQ, D), 1.0),
        'norm_mix_g': 1.0 + _normal(ks[1], (DEPTH, D), 0.01),
        'w_in': _normal(ks[2], (DEPTH, D, IN_WIDTH), D ** -0.5),
        'diff_q_norm_g': 1.0 + _normal(ks[3], (DEPTH, HEAD_DIM), 0.01),
        'diff_k_norm_g': 1.0 + _normal(ks[4], (DEPTH, HEAD_DIM), 0.01),
        'diff_lambda': _normal(ks[5], (DEPTH, 4, HEAD_DIM), 0.1),
        'diff_subln_g': 1.0 + _normal(ks[6], (DEPTH, DIFF_VDIM), 0.01),
        'w_gate': _normal(ks[7], (DEPTH, D, N_BRANCHES * D), D ** -0.5),
        'b_gate': _normal(ks[8], (DEPTH, N_BRANCHES * D), 0.02),
        'w_branch_sb': _normal(ks[9], (DEPTH, SB_WIDTH, D), SB_WIDTH ** -0.5),
        'w_branch_diff': _normal(ks[10], (DEPTH, DIFF_V_WIDTH, D), DIFF_V_WIDTH ** -0.5),
        'w_out': _normal(ks[11], (DEPTH, D, D), D ** -0.5),
        'norm_ffn_g': 1.0 + _normal(ks[12], (DEPTH, D), 0.01),
        'ffn_w_gate_up': _normal(ks[13], (N_DENSE, D, 2 * D_FF), D ** -0.5),
        'ffn_w_down': _normal(ks[14], (N_DENSE, D_FF, D), D_FF ** -0.5),
        'moe_w_router': _normal(ks[15], (N_MOE, D, N_EXPERTS), D ** -0.5),
        'moe_w1': _normal(ks[16], (N_MOE, N_EXPERTS, D, D_FF_EXPERT), D ** -0.5),
        'moe_w3': _normal(ks[17], (N_MOE, N_EXPERTS, D, D_FF_EXPERT), D ** -0.5),
        'moe_w2': _normal(ks[18], (N_MOE, N_EXPERTS, D_FF_EXPERT, D), D_FF_EXPERT ** -0.5),
    }


def reference(x, norm_mix_g, w_in, diff_q_norm_g, diff_k_norm_g, diff_lambda, diff_subln_g,
              w_gate, b_gate, w_branch_sb, w_branch_diff, w_out, norm_ffn_g,
              ffn_w_gate_up, ffn_w_down, moe_w_router, moe_w1, moe_w3, moe_w2):
    B, S, D = x.shape
    split_at = [int(c) for c in np.cumsum([SB_WIDTH, SB_WIDTH, SB_WIDTH, DIFF_QK_WIDTH, DIFF_QK_WIDTH])]
    for i in range(DEPTH):
        h = rms_norm(x, norm_mix_g[i])
        proj = h @ w_in[i]
        sb_q, sb_k, sb_v, df_q, df_k, df_v = jnp.split(proj, split_at, axis=-1)
        y_sb = stick_breaking_attention(
            sb_q.reshape(B, S, SB_HEADS, HEAD_DIM),
            sb_k.reshape(B, S, SB_HEADS, HEAD_DIM),
            sb_v.reshape(B, S, SB_HEADS, HEAD_DIM))
        df_q = rms_norm(df_q.reshape(B, S, DIFF_HEADS, 2, HEAD_DIM), diff_q_norm_g[i])
        df_k = rms_norm(df_k.reshape(B, S, DIFF_HEADS, 2, HEAD_DIM), diff_k_norm_g[i])
        lambda_init = 0.8 - 0.6 * math.exp(-0.3 * i)
        lq1, lk1, lq2, lk2 = diff_lambda[i].astype(jnp.float32)
        lam = jnp.exp(jnp.sum(lq1 * lk1)) - jnp.exp(jnp.sum(lq2 * lk2)) + lambda_init
        y_df = differential_attention(
            df_q, df_k, df_v.reshape(B, S, DIFF_HEADS, DIFF_VDIM),
            lam, lambda_init, diff_subln_g[i])
        gates = jax.nn.sigmoid(h @ w_gate[i] + b_gate[i]).reshape(B, S, N_BRANCHES, D)
        merged = gates[:, :, 0] * (y_sb @ w_branch_sb[i]) + gates[:, :, 1] * (y_df @ w_branch_diff[i])
        x = x + merged @ w_out[i]
        h = rms_norm(x, norm_ffn_g[i])
        j = i // 2
        if i % 2 == 0:
            x = x + swiglu(h, ffn_w_gate_up[j], ffn_w_down[j])
        else:
            x = x + moe_swiglu(h, moe_w_router[j], moe_w1[j], moe_w3[j], moe_w2[j])
    return x
```

```cpp
#include <hip/hip_runtime.h>
__device__ __forceinline__ int cur_tid() { int l; asm volatile("v_mbcnt_lo_u32_b32 %0, -1, 0\n\tv_mbcnt_hi_u32_b32 %0, -1, %0" : "=v"(l)); return (__builtin_amdgcn_readfirstlane((int)threadIdx.x >> 6) << 6) | l; }
#include <cstdio>
#include <cstdint>

namespace pg8 {
#define PG8_LAS __attribute__((address_space(3)))
typedef unsigned short bf16_t;
typedef short bf16x8 __attribute__((ext_vector_type(8)));
typedef float f32x4 __attribute__((ext_vector_type(4)));
typedef unsigned u32x4 __attribute__((ext_vector_type(4)));
constexpr int BM = 256, BK = 64, HALF = 128, HTB = HALF * BK * 2  , STAGE_BYTES = 8 * HTB, NXCD = 8, WGM = 8;

__host__ __device__ __forceinline__ int lds_byte(int r, int c) { const int st = (r >> 4) * 2 + (c >> 5), rr = r & 15, cc = c & 31, ob = rr * 64 + cc * 2; return st * 1024 + (ob ^ (((ob >> 9) & 1) << 5)); }
__host__ __device__ __forceinline__ void stage_rc(int b, int& R, int& C) { const int st = b / 1024, sb = b % 1024, swz = sb ^ (((sb >> 9) & 1) << 5); R = (st >> 1) * 16 + swz / 64; C = (st & 1) * 32 + (swz % 64) / 2; }
__host__ __device__ __forceinline__ int permv32(int rho) { const int n = rho >> 4, i = rho & 15, fq = i >> 2, e = i & 3; return 16 * (fq >> 1) + 8 * n + 4 * (fq & 1) + e; }
__host__ __device__ __forceinline__ int perm32(int rho) { const int n = rho >> 4, i = rho & 15; return 8 * (i >> 2) + 4 * n + (i & 3); }

struct Unit { int pm, pn, e, par; };
struct Gemm { const bf16_t* A; const bf16_t* Bt; int lda, K; };

struct StaticOrder {
    int nM, nN, nwg, G, c;
    __host__ __device__ void init(int M, int N, int G_, int c_) { nM = M / BM; nN = N / BM; nwg = nM * nN; G = G_; c = c_; }
    __host__ __device__ bool next(int i, Unit& u) const {
        const long L = (long)i * G + c; if (L >= nwg) return false;
        int wgid = (int)L; { const int q = nwg / NXCD, r = nwg % NXCD, xcd = wgid % NXCD, off = wgid / NXCD; wgid = (xcd < r ? xcd * (q + 1) : r * (q + 1) + (xcd - r) * q) + off; }
        const int nig = WGM * nN, gid = wgid / nig, fm = gid * WGM, gsz = (nM - fm) < WGM ? (nM - fm) : WGM;
        u.pm = fm + ((wgid % nig) % gsz); u.pn = (wgid % nig) / gsz; u.e = 0; return true;
    }
    __device__ __forceinline__ const char* a_ptr(const Gemm& g, const Unit& u) const { return (const char*)g.A + (size_t)u.pm * ((size_t)BM * g.lda * 2); }
    __device__ __forceinline__ const char* b_ptr(const Gemm& g, const Unit& u) const { return (const char*)g.Bt + (size_t)u.pn * ((size_t)BM * g.K * 2); }
    __device__ __forceinline__ void a_ready(const Unit&) const {}
    __device__ __forceinline__ void done(const Unit&) const {}
};
struct MoeOrder {
    int nM, nN, nwg, G, c, tile0, a_tile_off; int ts[9]; size_t b_exp_bytes;
    __device__ __forceinline__ void unit_at(long L, Unit& u) const {
        int wgid = (int)L; { const int q = nwg / NXCD, r = nwg % NXCD, xcd = wgid % NXCD, off = wgid / NXCD; wgid = (xcd < r ? xcd * (q + 1) : r * (q + 1) + (xcd - r) * q) + off; }
        const int nig = WGM * nN, gid = wgid / nig, fm = gid * WGM, gsz = (nM - fm) < WGM ? (nM - fm) : WGM;
        u.pm = fm + ((wgid % nig) % gsz); u.pn = (wgid % nig) / gsz;
        const int t = tile0 + u.pm; int e = 0;
#pragma unroll
        for (int j = 1; j < 8; ++j) e += (t >= ts[j]) ? 1 : 0;
        u.e = e;
    }
    __device__ __forceinline__ bool next(int i, Unit& u) const {
        const long L = (long)i * G + c; if (L >= nwg) return false;
        unit_at(L, u); return true;
    }
    __device__ __forceinline__ const char* a_ptr(const Gemm& g, const Unit& u) const { return (const char*)g.A + (size_t)(u.pm + a_tile_off) * ((size_t)BM * g.lda * 2); }
    __device__ __forceinline__ const char* b_ptr(const Gemm& g, const Unit& u) const { return (const char*)g.Bt + (size_t)u.e * b_exp_bytes + (size_t)u.pn * ((size_t)BM * g.K * 2); }
    __device__ __forceinline__ void a_ready(const Unit&) const {}
    __device__ __forceinline__ void done(const Unit&) const {}
};

struct QkOrder : StaticOrder {
    __device__ __forceinline__ bool next(int i, Unit& u) const { if (!StaticOrder::next(i, u)) return false; u.pn = u.pn < 4 ? u.pn : u.pn + 2; return true; }
};
struct GatesOrder : StaticOrder {
    __device__ __forceinline__ bool next(int i, Unit& u) const { if (!StaticOrder::next(i >> 1, u)) return false; u.pn += 4 * (i & 1); return true; }
};
struct VtOrder : StaticOrder {
    int rsb, rdf;
    __device__ __forceinline__ const char* a_ptr(const Gemm& g, const Unit& u) const { return (const char*)g.A + (size_t)(u.pm < 2 ? rsb + BM * u.pm : rdf + BM * (u.pm - 2)) * ((size_t)g.lda * 2); }
};

template <bool HFIRST, bool PUB> struct MoeDeal : MoeOrder {
    static constexpr bool h_first = HFIRST;
    int nH, hk; unsigned* pub; mutable int prev_pm;
    __device__ __forceinline__ bool next(int i, Unit& u) const {
        const int nheavy = nH * hk, jh = c - (G - nH); long L;
        if (jh >= 0) { if (i >= hk) return false; L = (h_first ? 0 : nwg - nheavy) + (long)i * nH + jh; }
        else { L = (h_first ? nheavy : 0) + (long)i * (G - nH) + c; if (L >= (h_first ? nwg : nwg - nheavy)) return false; }
        unit_at(L, u); return true;
    }
    __device__ __forceinline__ void done(const Unit& u) const {
        if constexpr (PUB) { asm volatile("s_waitcnt vmcnt(16)" ::: "memory");
            if (prev_pm >= 0 && ((cur_tid() & 63) == 0)) __hip_atomic_fetch_add(pub + 64 * prev_pm, 1u, __ATOMIC_RELAXED, __HIP_MEMORY_SCOPE_AGENT);
            prev_pm = u.pm; }
    }
    __device__ __forceinline__ void publish_last() const {
        if constexpr (PUB) { asm volatile("s_waitcnt vmcnt(0)" ::: "memory");
            if (prev_pm >= 0 && ((cur_tid() & 63) == 0)) __hip_atomic_fetch_add(pub + 64 * prev_pm, 1u, __ATOMIC_RELAXED, __HIP_MEMORY_SCOPE_AGENT);
            prev_pm = -1; }
    }
};

typedef float f32x2_t __attribute__((ext_vector_type(2))); typedef __bf16 bf16x2_t __attribute__((ext_vector_type(2)));
__device__ __forceinline__ unsigned cvt_pk_bf16(float lo, float hi) { f32x2_t v = {lo, hi}; bf16x2_t b = __builtin_convertvector(v, bf16x2_t); return __builtin_bit_cast(unsigned, b); }
typedef int v8i_t __attribute__((ext_vector_type(8)));
typedef int v4i_t __attribute__((ext_vector_type(4)));
__device__ __forceinline__ unsigned pack4_i8(float a, float b, float c, float d) {
    const int q0 = (int)__builtin_fminf(__builtin_fmaxf(__builtin_rintf(a), -127.f), 127.f), q1 = (int)__builtin_fminf(__builtin_fmaxf(__builtin_rintf(b), -127.f), 127.f);
    const int q2 = (int)__builtin_fminf(__builtin_fmaxf(__builtin_rintf(c), -127.f), 127.f), q3 = (int)__builtin_fminf(__builtin_fmaxf(__builtin_rintf(d), -127.f), 127.f);
    return (unsigned)(q0 & 255) | ((unsigned)(q1 & 255) << 8) | ((unsigned)(q2 & 255) << 16) | ((unsigned)(q3 & 255) << 24); }
__device__ __forceinline__ v8i_t cat8(bf16x8 lo, bf16x8 hi) { const u32x4 a = __builtin_bit_cast(u32x4, lo), b = __builtin_bit_cast(u32x4, hi); return (v8i_t){(int)a.x, (int)a.y, (int)a.z, (int)a.w, (int)b.x, (int)b.y, (int)b.z, (int)b.w}; }
__device__ __forceinline__ void mfma_f8_acc(f32x4& acc, const v8i_t& b, const v8i_t& a, int sc) { asm volatile("v_mfma_scale_f32_16x16x128_f8f6f4 %0, %1, %2, %0, %3, %3 op_sel_hi:[0,0,0]" : "+v"(acc) : "v"(b), "v"(a), "v"(sc)); }
__device__ __forceinline__ float clamp_f8(float v) { return __builtin_fminf(__builtin_fmaxf(v, -448.f), 448.f); }
__device__ __forceinline__ unsigned pack4_f8(float a, float b, float c, float d) { unsigned w = 0u; w = __builtin_amdgcn_cvt_pk_fp8_f32(clamp_f8(a), clamp_f8(b), w, false); w = __builtin_amdgcn_cvt_pk_fp8_f32(clamp_f8(c), clamp_f8(d), w, true); return w; }
__device__ __forceinline__ float bf_lo(unsigned w) { return __uint_as_float(w << 16); }
__device__ __forceinline__ float bf_hi(unsigned w) { return __uint_as_float(w & 0xffff0000u); }
__device__ __forceinline__ float sigmoid_f(float v) { return __builtin_amdgcn_rcpf(1.0f + __expf(-v)); }

template <int ACT> struct EpiStoreBf16 {
    static constexpr bool STAGE = false; static constexpr bool PERM = true, PERMV = false, AFTER_DRAIN = false;
    bf16_t* O; int ldc; const float* bias;
    __device__ __forceinline__ void operator()(const f32x4 (&acc)[2][2][4][2], const Unit& u, int wr, int wc, int fr, int fq) const {
        const int row0 = u.pm * BM + wr * 64 + fr, col0 = u.pn * BM + wc * 32 + 8 * fq;
        f32x4 bv[2][2];
#pragma unroll
        for (int bj = 0; bj < 2; ++bj)
#pragma unroll
            for (int n = 0; n < 2; ++n) bv[bj][n] = bias ? *(const f32x4*)(bias + col0 + bj * HALF + 4 * n) : (f32x4){0.f, 0.f, 0.f, 0.f};
#pragma unroll
        for (int ai = 0; ai < 2; ++ai)
#pragma unroll
            for (int m = 0; m < 4; ++m) { bf16_t* rowp = O + (size_t)(row0 + ai * HALF + m * 16) * ldc + col0;
#pragma unroll
                for (int bj = 0; bj < 2; ++bj) { f32x4 v0 = acc[ai][bj][m][0] + bv[bj][0], v1 = acc[ai][bj][m][1] + bv[bj][1];
                    if (ACT == 2) {
#pragma unroll
                        for (int j = 0; j < 4; ++j) { v0[j] = sigmoid_f(v0[j]); v1[j] = sigmoid_f(v1[j]); } }
                    u32x4 w; w.x = cvt_pk_bf16(v0[0], v0[1]); w.y = cvt_pk_bf16(v0[2], v0[3]); w.z = cvt_pk_bf16(v1[0], v1[1]); w.w = cvt_pk_bf16(v1[2], v1[3]);
                    *(u32x4*)(rowp + bj * HALF) = w; } }
    }
};
template <bool ACCUM> struct EpiGateMul {
    static constexpr bool STAGE = false; static constexpr bool PERM = true, PERMV = false, AFTER_DRAIN = false;
    bf16_t* O; int ldo; const bf16_t* Gt; int ldg;
    __device__ __forceinline__ void operator()(const f32x4 (&acc)[2][2][4][2], const Unit& u, int wr, int wc, int fr, int fq) const {
        const int row0 = u.pm * BM + wr * 64 + fr, col0 = u.pn * BM + wc * 32 + 8 * fq;
#pragma unroll
        for (int ai = 0; ai < 2; ++ai) {
            u32x4 gv[4][2], pv[4][2];
#pragma unroll
            for (int m = 0; m < 4; ++m)
#pragma unroll
                for (int bj = 0; bj < 2; ++bj) { const size_t row = (size_t)(row0 + ai * HALF + m * 16); const int col = col0 + bj * HALF;
                    gv[m][bj] = *(const u32x4*)(Gt + row * ldg + col); if (ACCUM) pv[m][bj] = *(const u32x4*)(O + row * ldo + col); }
#pragma unroll
            for (int m = 0; m < 4; ++m)
#pragma unroll
                for (int bj = 0; bj < 2; ++bj) { const size_t row = (size_t)(row0 + ai * HALF + m * 16); const int col = col0 + bj * HALF;
                    const u32x4 gw = gv[m][bj]; f32x4 v0 = acc[ai][bj][m][0], v1 = acc[ai][bj][m][1];
                    v0[0] *= bf_lo(gw.x); v0[1] *= bf_hi(gw.x); v0[2] *= bf_lo(gw.y); v0[3] *= bf_hi(gw.y);
                    v1[0] *= bf_lo(gw.z); v1[1] *= bf_hi(gw.z); v1[2] *= bf_lo(gw.w); v1[3] *= bf_hi(gw.w);
                    if (ACCUM) { const u32x4 pw = pv[m][bj];
                        v0[0] += bf_lo(pw.x); v0[1] += bf_hi(pw.x); v0[2] += bf_lo(pw.y); v0[3] += bf_hi(pw.y);
                        v1[0] += bf_lo(pw.z); v1[1] += bf_hi(pw.z); v1[2] += bf_lo(pw.w); v1[3] += bf_hi(pw.w); }
                    u32x4 w; w.x = cvt_pk_bf16(v0[0], v0[1]); w.y = cvt_pk_bf16(v0[2], v0[3]); w.z = cvt_pk_bf16(v1[0], v1[1]); w.w = cvt_pk_bf16(v1[2], v1[3]);
                    *(u32x4*)(O + row * ldo + col) = w; }
        }
    }
};
struct EpiResF32 {
    static constexpr bool STAGE = false; static constexpr bool PERM = false, PERMV = false, AFTER_DRAIN = false;
    const float* base; float* out; int ldc;
    __device__ __forceinline__ void operator()(const f32x4 (&acc)[2][2][4][2], const Unit& u, int wr, int wc, int fr, int fq) const {
        const int col0 = u.pn * BM + wc * 32 + 4 * fq;
#pragma unroll
        for (int ai = 0; ai < 2; ++ai) {
            f32x4 bs[4][2][2];
#pragma unroll
            for (int m = 0; m < 4; ++m) { const size_t off = (size_t)(u.pm * BM + ai * HALF + wr * 64 + m * 16 + fr) * ldc + col0;
#pragma unroll
                for (int bj = 0; bj < 2; ++bj)
#pragma unroll
                    for (int n = 0; n < 2; ++n) bs[m][bj][n] = *(const f32x4*)(base + off + bj * HALF + n * 16); }
#pragma unroll
            for (int m = 0; m < 4; ++m) { const size_t off = (size_t)(u.pm * BM + ai * HALF + wr * 64 + m * 16 + fr) * ldc + col0;
#pragma unroll
                for (int bj = 0; bj < 2; ++bj)
#pragma unroll
                    for (int n = 0; n < 2; ++n) *(f32x4*)(out + off + bj * HALF + n * 16) = bs[m][bj][n] + acc[ai][bj][m][n]; }
        }
    }
};
template <bool SC> struct EpiResBfT {
    static constexpr bool STAGE = false; static constexpr bool PERM = true, PERMV = false, AFTER_DRAIN = false; static constexpr int NST = 0;
    const float* basef; int ldf; bf16_t* xb; int ldb; float ascale;
    __device__ __forceinline__ void operator()(const f32x4 (&acc)[2][2][4][2], const Unit& u, int wr, int wc, int fr, int fq) const {
        const int col0 = u.pn * BM + wc * 32 + 8 * fq;
#pragma unroll
        for (int ai = 0; ai < 2; ++ai) {
            if constexpr (SC) {
                u32x4 wv[4][2];
#pragma unroll
                for (int m = 0; m < 4; ++m) { const size_t row = (size_t)(u.pm * BM + ai * HALF + wr * 64 + m * 16 + fr);
#pragma unroll
                    for (int bj = 0; bj < 2; ++bj) wv[m][bj] = *(const u32x4*)(xb + row * ldb + col0 + bj * HALF); }
#pragma unroll
                for (int m = 0; m < 4; ++m) { const size_t row = (size_t)(u.pm * BM + ai * HALF + wr * 64 + m * 16 + fr);
#pragma unroll
                    for (int bj = 0; bj < 2; ++bj) { const u32x4 w0 = wv[m][bj];
                        const f32x4 v0 = (f32x4){bf_lo(w0.x), bf_hi(w0.x), bf_lo(w0.y), bf_hi(w0.y)} + acc[ai][bj][m][0] * ascale, v1 = (f32x4){bf_lo(w0.z), bf_hi(w0.z), bf_lo(w0.w), bf_hi(w0.w)} + acc[ai][bj][m][1] * ascale;
                        u32x4 w; w.x = cvt_pk_bf16(v0[0], v0[1]); w.y = cvt_pk_bf16(v0[2], v0[3]); w.z = cvt_pk_bf16(v1[0], v1[1]); w.w = cvt_pk_bf16(v1[2], v1[3]);
                        *(u32x4*)(xb + row * ldb + col0 + bj * HALF) = w; } }
                continue; }
            f32x4 b0[4][2], b1[4][2];
#pragma unroll
            for (int m = 0; m < 4; ++m) { const size_t row = (size_t)(u.pm * BM + ai * HALF + wr * 64 + m * 16 + fr);
#pragma unroll
                for (int bj = 0; bj < 2; ++bj) { const int col = col0 + bj * HALF;
                    if (basef) { b0[m][bj] = *(const f32x4*)(basef + row * ldf + col); b1[m][bj] = *(const f32x4*)(basef + row * ldf + col + 4); }
                    else { const u32x4 w = *(const u32x4*)(xb + row * ldb + col);
                        b0[m][bj] = (f32x4){bf_lo(w.x), bf_hi(w.x), bf_lo(w.y), bf_hi(w.y)}; b1[m][bj] = (f32x4){bf_lo(w.z), bf_hi(w.z), bf_lo(w.w), bf_hi(w.w)}; } } }
#pragma unroll
            for (int m = 0; m < 4; ++m) { const size_t row = (size_t)(u.pm * BM + ai * HALF + wr * 64 + m * 16 + fr);
#pragma unroll
                for (int bj = 0; bj < 2; ++bj) { const f32x4 v0 = b0[m][bj] + acc[ai][bj][m][0], v1 = b1[m][bj] + acc[ai][bj][m][1];
                    u32x4 w; w.x = cvt_pk_bf16(v0[0], v0[1]); w.y = cvt_pk_bf16(v0[2], v0[3]); w.z = cvt_pk_bf16(v1[0], v1[1]); w.w = cvt_pk_bf16(v1[2], v1[3]);
                    *(u32x4*)(xb + row * ldb + col0 + bj * HALF) = w; } }
        }
    }
};
using EpiResBf = EpiResBfT<false>; using EpiResBf8 = EpiResBfT<true>;
struct EpiSwiglu {
    static constexpr bool STAGE = false; static constexpr bool PERM = true, PERMV = false, AFTER_DRAIN = false;
    bf16_t* O; int ldo;
    __device__ __forceinline__ void operator()(const f32x4 (&acc)[2][2][4][2], const Unit& u, int wr, int wc, int fr, int fq) const {
        const int row0 = u.pm * BM + wr * 64 + fr, col0 = u.pn * HALF + wc * 32 + 8 * fq;
#pragma unroll
        for (int ai = 0; ai < 2; ++ai)
#pragma unroll
            for (int m = 0; m < 4; ++m) { bf16_t* op = O + (size_t)(row0 + ai * HALF + m * 16) * ldo + col0;
                f32x4 h0, h1;
#pragma unroll
                for (int j = 0; j < 4; ++j) { const float g0 = acc[ai][0][m][0][j], g1 = acc[ai][0][m][1][j];
                    h0[j] = g0 * sigmoid_f(g0) * acc[ai][1][m][0][j]; h1[j] = g1 * sigmoid_f(g1) * acc[ai][1][m][1][j]; }
                u32x4 w; w.x = cvt_pk_bf16(h0[0], h0[1]); w.y = cvt_pk_bf16(h0[2], h0[3]); w.z = cvt_pk_bf16(h1[0], h1[1]); w.w = cvt_pk_bf16(h1[2], h1[3]);
                *(u32x4*)op = w; }
    }
};
struct EpiMoeScatter {
    static constexpr bool STAGE = false; static constexpr bool PERM = false, PERMV = false, AFTER_DRAIN = false;
    float* out; int ldc; const int* slot_tok; const float* slot_w; int slot0;
    __device__ __forceinline__ void operator()(const f32x4 (&acc)[2][2][4][2], const Unit& u, int wr, int wc, int fr, int fq) const {
        const int col0 = u.pn * BM + wc * 32 + 4 * fq;
#pragma unroll
        for (int ai = 0; ai < 2; ++ai)
#pragma unroll
            for (int m = 0; m < 4; ++m) { const int slot = slot0 + u.pm * BM + ai * HALF + wr * 64 + m * 16 + fr;
                const int tok = slot_tok[slot]; const float w = slot_w[slot];
                if (tok >= 0) { float* op = out + (size_t)tok * ldc + col0;
#pragma unroll
                    for (int bj = 0; bj < 2; ++bj)
#pragma unroll
                        for (int n = 0; n < 2; ++n) { const f32x4 v = acc[ai][bj][m][n] * w; float* p = op + bj * HALF + n * 16;
                            unsafeAtomicAdd(p + 0, v[0]); unsafeAtomicAdd(p + 1, v[1]); unsafeAtomicAdd(p + 2, v[2]); unsafeAtomicAdd(p + 3, v[3]); } } }
    }
};
struct EpiMoeStore {
    static constexpr bool STAGE = false; static constexpr bool PERM = true, PERMV = false, AFTER_DRAIN = false;
    bf16_t* O; int ldo; const float* slot_w; int slot0; float ascale;
    __device__ __forceinline__ void operator()(const f32x4 (&acc)[2][2][4][2], const Unit& u, int wr, int wc, int fr, int fq) const {
        const int row0 = slot0 + u.pm * BM + wr * 64 + fr, col0 = u.pn * BM + wc * 32 + 8 * fq;
        float wv[2][4];
#pragma unroll
        for (int ai = 0; ai < 2; ++ai)
#pragma unroll
            for (int m = 0; m < 4; ++m) wv[ai][m] = slot_w[row0 + ai * HALF + m * 16];
#pragma unroll
        for (int ai = 0; ai < 2; ++ai)
#pragma unroll
            for (int m = 0; m < 4; ++m) wv[ai][m] *= ascale;
#pragma unroll
        for (int ai = 0; ai < 2; ++ai)
#pragma unroll
            for (int m = 0; m < 4; ++m) { const int slot = row0 + ai * HALF + m * 16; const float w = wv[ai][m]; bf16_t* rowp = O + (size_t)slot * ldo + col0;
#pragma unroll
                for (int bj = 0; bj < 2; ++bj) { const f32x4 v0 = acc[ai][bj][m][0] * w, v1 = acc[ai][bj][m][1] * w;
                    u32x4 o; o.x = cvt_pk_bf16(v0[0], v0[1]); o.y = cvt_pk_bf16(v0[2], v0[3]); o.z = cvt_pk_bf16(v1[0], v1[1]); o.w = cvt_pk_bf16(v1[2], v1[3]);
                    *(u32x4*)(rowp + bj * HALF) = o; } }
    }
};
struct EpiSwiglu8 {
    static constexpr bool STAGE = false; static constexpr bool PERM = true, PERMV = false, AFTER_DRAIN = false;
    unsigned char* O; int ldo; float ascale;
    __device__ __forceinline__ void operator()(const f32x4 (&acc)[2][2][4][2], const Unit& u, int wr, int wc, int fr, int fq) const {
        const int row0 = u.pm * BM + wr * 64 + fr, col0 = u.pn * HALF + wc * 32 + 8 * fq;
        const float k1 = -1.4426950408889634f * ascale, ic = 1.f / (ascale * ascale), lc = __builtin_amdgcn_logf(ic);
#pragma unroll
        for (int ai = 0; ai < 2; ++ai)
#pragma unroll
            for (int m = 0; m < 4; ++m) { unsigned char* op = O + (size_t)(row0 + ai * HALF + m * 16) * ldo + col0;
                float e[8], t[8];
#pragma unroll
                for (int j = 0; j < 4; ++j) { const float ga = acc[ai][0][m][0][j], gb = acc[ai][0][m][1][j];
                    e[j] = __builtin_amdgcn_exp2f(__builtin_fmaf(ga, k1, lc)); e[4 + j] = __builtin_amdgcn_exp2f(__builtin_fmaf(gb, k1, lc));
                    t[j] = ga * acc[ai][1][m][0][j]; t[4 + j] = gb * acc[ai][1][m][1][j]; }
#pragma unroll
                for (int j = 0; j < 8; ++j) e[j] = __builtin_amdgcn_rcpf(e[j] + ic);
#pragma unroll
                for (int j = 0; j < 8; ++j) t[j] *= e[j];
                typedef unsigned u32x2 __attribute__((ext_vector_type(2)));
                __hip_atomic_store((unsigned long long*)op, (unsigned long long)pack4_f8(t[0], t[1], t[2], t[3]) | ((unsigned long long)pack4_f8(t[4], t[5], t[6], t[7]) << 32), __ATOMIC_RELAXED, __HIP_MEMORY_SCOPE_AGENT); }
    }
};
struct EpiResF32S {
    static constexpr bool STAGE = false; static constexpr bool PERM = false, PERMV = false, AFTER_DRAIN = false;
    const float* base; float* out; int ldc; float ascale;
    __device__ __forceinline__ void operator()(const f32x4 (&acc)[2][2][4][2], const Unit& u, int wr, int wc, int fr, int fq) const {
        const int col0 = u.pn * BM + wc * 32 + 4 * fq;
#pragma unroll
        for (int ai = 0; ai < 2; ++ai)
#pragma unroll
            for (int m = 0; m < 4; ++m) { const size_t off = (size_t)(u.pm * BM + ai * HALF + wr * 64 + m * 16 + fr) * ldc + col0;
#pragma unroll
                for (int bj = 0; bj < 2; ++bj)
#pragma unroll
                    for (int n = 0; n < 2; ++n) { const f32x4 bs = *(const f32x4*)(base + off + bj * HALF + n * 16); *(f32x4*)(out + off + bj * HALF + n * 16) = bs + acc[ai][bj][m][n] * ascale; } }
    }
};
typedef int i32x4_t __attribute__((ext_vector_type(4)));
__device__ __forceinline__ f32x4 acc_i2f(const f32x4& a, float s) { return __builtin_convertvector(__builtin_bit_cast(i32x4_t, a), f32x4) * s; }
__device__ __forceinline__ f32x4 acc_i2f_again(const f32x4& a, float s) { i32x4_t t = __builtin_bit_cast(i32x4_t, a); asm volatile("" : "+v"(t)); return __builtin_convertvector(t, f32x4) * s; }
template <int ACT> struct EpiStoreBf16Q {
    static constexpr bool STAGE = (ACT == 2); static constexpr bool PERM = true, PERMV = false, AFTER_DRAIN = false;
    bf16_t* O; int ldc; const float* bias; const float* sa; const float* swc; PG8_LAS float* ls;
    __device__ __forceinline__ void stage(const Unit& u, int wid, int lane) const {
        PG8_LAS float* d = ls + u.par * 1024;
        const float* src = wid < 4 ? sa + u.pm * BM + 64 * wid : swc + u.pn * BM + 64 * (wid - 4);
        __builtin_amdgcn_global_load_lds((const unsigned*)(src + lane), (PG8_LAS unsigned*)(d + 64 * wid), 4, 0, 0);
        if (wid < 4) __builtin_amdgcn_global_load_lds((const unsigned*)(bias + u.pn * BM + 64 * wid + lane), (PG8_LAS unsigned*)(d + 512 + 64 * wid), 4, 0, 0);
    }
    __device__ __forceinline__ void operator()(const f32x4 (&acc)[2][2][4][2], const Unit& u, int wr, int wc, int fr, int fq) const {
        const int row0 = u.pm * BM + wr * 64 + fr, col0 = u.pn * BM + wc * 32 + 8 * fq;
        f32x4 bv[2][2], cs[2][2]; float rsv[2][4];
        if constexpr (STAGE) {
            int db = u.par * 1024; asm volatile("" : "+v"(db));
            const PG8_LAS float* d = ls + db;
#pragma unroll
            for (int bj = 0; bj < 2; ++bj)
#pragma unroll
                for (int n = 0; n < 2; ++n) { cs[bj][n] = *(const PG8_LAS f32x4*)(d + 256 + wc * 32 + 8 * fq + bj * HALF + 4 * n); bv[bj][n] = *(const PG8_LAS f32x4*)(d + 512 + wc * 32 + 8 * fq + bj * HALF + 4 * n); }
#pragma unroll
            for (int ai = 0; ai < 2; ++ai)
#pragma unroll
                for (int m = 0; m < 4; ++m) rsv[ai][m] = d[wr * 64 + fr + ai * HALF + m * 16];
        } else {
#pragma unroll
        for (int bj = 0; bj < 2; ++bj)
#pragma unroll
            for (int n = 0; n < 2; ++n) { bv[bj][n] = bias ? *(const f32x4*)(bias + col0 + bj * HALF + 4 * n) : (f32x4){0.f, 0.f, 0.f, 0.f}; cs[bj][n] = *(const f32x4*)(swc + col0 + bj * HALF + 4 * n); }
#pragma unroll
        for (int ai = 0; ai < 2; ++ai)
#pragma unroll
            for (int m = 0; m < 4; ++m) rsv[ai][m] = sa[row0 + ai * HALF + m * 16];
        }
#pragma unroll
        for (int ai = 0; ai < 2; ++ai)
#pragma unroll
            for (int m = 0; m < 4; ++m) { const int row = row0 + ai * HALF + m * 16; bf16_t* rowp = O + (size_t)row * ldc + col0; const float rs = rsv[ai][m];
#pragma unroll
                for (int bj = 0; bj < 2; ++bj) { f32x4 v0 = acc_i2f(acc[ai][bj][m][0], rs) * cs[bj][0] + bv[bj][0], v1 = acc_i2f(acc[ai][bj][m][1], rs) * cs[bj][1] + bv[bj][1];
                    if (ACT == 2) {
#pragma unroll
                        for (int j = 0; j < 4; ++j) { v0[j] = sigmoid_f(v0[j]); v1[j] = sigmoid_f(v1[j]); } }
                    u32x4 w; w.x = cvt_pk_bf16(v0[0], v0[1]); w.y = cvt_pk_bf16(v0[2], v0[3]); w.z = cvt_pk_bf16(v1[0], v1[1]); w.w = cvt_pk_bf16(v1[2], v1[3]);
                    *(u32x4*)(rowp + bj * HALF) = w; } }
    }
};
template <bool F8OUT> struct EpiSwigluQT {
    static constexpr bool STAGE = F8OUT; static constexpr bool PERM = true, PERMV = false, AFTER_DRAIN = false;
    bf16_t* O; int ldo; const float* sa; const float* swg; const float* swu; PG8_LAS float* ls;
    __device__ __forceinline__ void stage(const Unit& u, int wid, int lane) const {
        const float* src = wid < 4 ? sa + u.pm * BM + 64 * wid : (wid < 6 ? swg + u.pn * HALF + 64 * (wid - 4) : swu + u.pn * HALF + 64 * (wid - 6));
        __builtin_amdgcn_global_load_lds((const unsigned*)(src + lane), (PG8_LAS unsigned*)(ls + u.par * 512 + 64 * wid), 4, 0, 0);
    }
    __device__ __forceinline__ void operator()(const f32x4 (&acc)[2][2][4][2], const Unit& u, int wr, int wc, int fr, int fq) const {
        const int row0 = u.pm * BM + wr * 64 + fr, col0 = u.pn * HALF + wc * 32 + 8 * fq;
        f32x4 g0s, g1s, u0s, u1s; float rsv[2][4];
        if constexpr (STAGE) {
            int db = u.par * 512; asm volatile("" : "+v"(db));
            const PG8_LAS float* d = ls + db;
            g0s = *(const PG8_LAS f32x4*)(d + 256 + wc * 32 + 8 * fq); g1s = *(const PG8_LAS f32x4*)(d + 256 + wc * 32 + 8 * fq + 4);
            u0s = *(const PG8_LAS f32x4*)(d + 384 + wc * 32 + 8 * fq); u1s = *(const PG8_LAS f32x4*)(d + 384 + wc * 32 + 8 * fq + 4);
#pragma unroll
            for (int ai = 0; ai < 2; ++ai)
#pragma unroll
                for (int m = 0; m < 4; ++m) rsv[ai][m] = d[wr * 64 + fr + ai * HALF + m * 16];
        } else {
        g0s = *(const f32x4*)(swg + col0); g1s = *(const f32x4*)(swg + col0 + 4); u0s = *(const f32x4*)(swu + col0); u1s = *(const f32x4*)(swu + col0 + 4);
#pragma unroll
        for (int ai = 0; ai < 2; ++ai)
#pragma unroll
            for (int m = 0; m < 4; ++m) rsv[ai][m] = sa[row0 + ai * HALF + m * 16];
        }
#pragma unroll
        for (int ai = 0; ai < 2; ++ai)
#pragma unroll
            for (int m = 0; m < 4; ++m) { const int row = row0 + ai * HALF + m * 16; bf16_t* op = O + (size_t)row * ldo + col0; const float rs = rsv[ai][m];
                const f32x4 ga = acc_i2f(acc[ai][0][m][0], rs) * g0s, gb = acc_i2f(acc[ai][0][m][1], rs) * g1s, ua = acc_i2f(acc[ai][1][m][0], rs) * u0s, ub = acc_i2f(acc[ai][1][m][1], rs) * u1s;
                f32x4 h0, h1;
#pragma unroll
                for (int j = 0; j < 4; ++j) { h0[j] = ga[j] * sigmoid_f(ga[j]) * ua[j]; h1[j] = gb[j] * sigmoid_f(gb[j]) * ub[j]; }
                if constexpr (F8OUT) { typedef unsigned u32x2 __attribute__((ext_vector_type(2)));
                    *(u32x2*)((unsigned char*)O + (size_t)row * ldo + col0) = (u32x2){pack4_f8(h0[0], h0[1], h0[2], h0[3]), pack4_f8(h1[0], h1[1], h1[2], h1[3])}; }
                else { u32x4 w; w.x = cvt_pk_bf16(h0[0], h0[1]); w.y = cvt_pk_bf16(h0[2], h0[3]); w.z = cvt_pk_bf16(h1[0], h1[1]); w.w = cvt_pk_bf16(h1[2], h1[3]);
                    *(u32x4*)op = w; } }
    }
};
using EpiSwigluQ = EpiSwigluQT<false>; using EpiSwigluQ8 = EpiSwigluQT<true>;

template <class Epi, class Sched, bool ALIGN_EPI = false, bool SP2 = false, int QM = 0>
__device__ __forceinline__ void gemm_phase(PG8_LAS unsigned char* lds, const Gemm g, const Sched& S, const Epi& E) {
    constexpr bool F8 = (QM == 1), I8 = (QM == 2);
    int tid_ = cur_tid();
    const int tid = tid_, wid = __builtin_amdgcn_readfirstlane(tid >> 6), lane = tid & 63, wr = wid >> 2, wc = wid & 3, fr = lane & 15, fq = lane >> 4;
    const int K = g.K, nt = K / BK;
    unsigned voffA[2], voffB[2];
#pragma unroll
    for (int i = 0; i < 2; ++i) { int R, C; stage_rc(tid * 16 + i * 8192, R, C); const int Rb = Epi::PERM ? ((R & ~31) + perm32(R & 31)) : (Epi::PERMV ? ((R & ~31) + permv32(R & 31)) : R);
        voffA[i] = (unsigned)(R * g.lda + C) * 2u; voffB[i] = (unsigned)(Rb * K + C) * 2u; }
    const size_t kstep = (size_t)(BK * 2);
    const size_t hstepA = (size_t)HALF * g.lda * 2, hstepB = (size_t)HALF * K * 2;
    const unsigned ldsw = (unsigned)wid * 1024u;
    const int aoff = lds_byte(wr * 64 + fr, fq * 8), boff = lds_byte(wc * 32 + fr, fq * 8);
#define PG8_SA(b, h) (((b) * 2 + (h)) * HTB)
#define PG8_SB(b, h) ((4 + (b) * 2 + (h)) * HTB)
#define PG8_STAGE(bufoff, gbase, voff) do { _Pragma("unroll") for (int _i = 0; _i < 2; ++_i) \
        __builtin_amdgcn_global_load_lds((const unsigned*)((const char*)(gbase) + (voff)[_i]), (PG8_LAS unsigned*)(lds + (bufoff) + ldsw + _i * 8192), 16, 0, 0); } while (0)
#define PG8_LDA(dst, b, h) do { if constexpr (F8) { _Pragma("unroll") for (int m = 0; m < 4; ++m) { dst##8[m].lo = *(const PG8_LAS v4i_t*)(lds + PG8_SA(b, h) + aoff + m * 2048); dst##8[m].hi = *(const PG8_LAS v4i_t*)(lds + PG8_SA(b, h) + aoff + m * 2048 + 1024); } } \
    else { _Pragma("unroll") for (int m = 0; m < 4; ++m) _Pragma("unroll") for (int k = 0; k < 2; ++k) dst[m][k] = *(const PG8_LAS bf16x8*)(lds + PG8_SA(b, h) + aoff + m * 2048 + k * 1024); } } while (0)
#define PG8_LDB(dst, b, h) do { if constexpr (F8) { _Pragma("unroll") for (int n = 0; n < 2; ++n) { dst##8[n].lo = *(const PG8_LAS v4i_t*)(lds + PG8_SB(b, h) + boff + n * 2048); dst##8[n].hi = *(const PG8_LAS v4i_t*)(lds + PG8_SB(b, h) + boff + n * 2048 + 1024); } } \
    else { _Pragma("unroll") for (int n = 0; n < 2; ++n) _Pragma("unroll") for (int k = 0; k < 2; ++k) dst[n][k] = *(const PG8_LAS bf16x8*)(lds + PG8_SB(b, h) + boff + n * 2048 + k * 1024); } } while (0)
#define PG8_MMA(ai, bj, At, Bt) do { __builtin_amdgcn_s_setprio(1); if constexpr (F8) { _Pragma("unroll") for (int m = 0; m < 4; ++m) _Pragma("unroll") for (int n = 0; n < 2; ++n) \
        mfma_f8_acc(acc[ai][bj][m][n], Bt##8[n], At##8[m], f8_one); } \
    else if constexpr (I8) { _Pragma("unroll") for (int m = 0; m < 4; ++m) _Pragma("unroll") for (int n = 0; n < 2; ++n) _Pragma("unroll") for (int k = 0; k < 2; ++k) \
        acc[ai][bj][m][n] = __builtin_bit_cast(f32x4, __builtin_amdgcn_mfma_i32_16x16x64_i8(__builtin_bit_cast(v4i_t, Bt[n][k]), __builtin_bit_cast(v4i_t, At[m][k]), __builtin_bit_cast(v4i_t, acc[ai][bj][m][n]), 0, 0, 0)); } \
    else { _Pragma("unroll") for (int m = 0; m < 4; ++m) _Pragma("unroll") for (int n = 0; n < 2; ++n) _Pragma("unroll") for (int k = 0; k < 2; ++k) \
        acc[ai][bj][m][n] = __builtin_amdgcn_mfma_f32_16x16x32_bf16(Bt[n][k], At[m][k], acc[ai][bj][m][n], 0, 0, 0); } __builtin_amdgcn_s_setprio(0); } while (0)
#define PG8_UNI(p_) ((const char*)(((unsigned long long)(unsigned)__builtin_amdgcn_readfirstlane((unsigned)((unsigned long long)(p_) >> 32)) << 32) | (unsigned)__builtin_amdgcn_readfirstlane((unsigned)(unsigned long long)(p_))))
#define PG8_WAIT_V(n) asm volatile("s_waitcnt vmcnt(" #n ")" ::: "memory")
#define PG8_WAIT_L(n) asm volatile("s_waitcnt lgkmcnt(" #n ")" ::: "memory")
#define PG8_BAR __builtin_amdgcn_s_barrier()
#define PG8_SCHED __builtin_amdgcn_sched_barrier(0)
    Unit cur, nxt; int ui = 0;
    if (!S.next(0, cur)) return;
    f32x4 acc[2][2][4][2];
#pragma unroll
    for (int a = 0; a < 2; ++a)
#pragma unroll
        for (int b = 0; b < 2; ++b)
#pragma unroll
            for (int m = 0; m < 4; ++m)
#pragma unroll
                for (int n = 0; n < 2; ++n) acc[a][b][m][n] = (f32x4){0.f, 0.f, 0.f, 0.f};
    bf16x8 At[4][2], B0[2][2], B1[2][2];
    v8i_t At8[4], B08[2], B18[2];
    const char* cA = S.a_ptr(g, cur); const char* cB = S.b_ptr(g, cur);
    S.a_ready(cur);
    if constexpr (SP2) {
        PG8_STAGE(PG8_SB(0, 0), cB, voffB); PG8_STAGE(PG8_SB(0, 1), cB + hstepB, voffB); PG8_STAGE(PG8_SA(0, 0), cA, voffA); PG8_STAGE(PG8_SA(0, 1), cA + hstepA, voffA);
        if (wr == 1) PG8_BAR;
        PG8_WAIT_V(2); PG8_BAR;
        PG8_STAGE(PG8_SB(1, 0), cB + kstep, voffB); PG8_STAGE(PG8_SA(1, 0), cA + kstep, voffA); PG8_STAGE(PG8_SB(1, 1), cB + hstepB + kstep, voffB);
        PG8_WAIT_V(6); PG8_BAR;
    } else {
        PG8_STAGE(PG8_SB(0, 0), cB, voffB); PG8_STAGE(PG8_SA(0, 0), cA, voffA); PG8_STAGE(PG8_SB(0, 1), cB + hstepB, voffB); PG8_STAGE(PG8_SA(0, 1), cA + hstepA, voffA);
        if (wr == 1) PG8_BAR;
        PG8_WAIT_V(4); PG8_BAR;
        PG8_STAGE(PG8_SB(1, 0), cB + kstep, voffB); PG8_STAGE(PG8_SA(1, 0), cA + kstep, voffA); PG8_STAGE(PG8_SB(1, 1), cB + hstepB + kstep, voffB);
        PG8_WAIT_V(6); PG8_BAR;
    }
    int f8_one = 0x7f7f7f7f; asm volatile("" : "+v"(f8_one));
    for (;;) {
        cur.par = ui & 1;
        if constexpr (Epi::STAGE) E.stage(cur, wid, lane);
        const bool has_next = S.next(ui + 1, nxt);
        const char* nA = has_next ? S.a_ptr(g, nxt) : cA; const char* nB = has_next ? S.b_ptr(g, nxt) : cB;
        for (int t = 0; t < nt; t += 2) {
            const bool last = (t == nt - 2);
            const char* a1 = PG8_UNI(cA + (size_t)(t + 1) * kstep);
            const char* a2 = PG8_UNI(last ? nA : cA + (size_t)(t + 2) * kstep); const char* b2 = PG8_UNI(last ? nB : cB + (size_t)(t + 2) * kstep);
            const char* a3 = a2 + kstep; const char* b3 = b2 + kstep;
            if (last && has_next) S.a_ready(nxt);
            if constexpr (SP2) {
            PG8_LDB(B0, 0, 0); PG8_LDB(B1, 0, 1); PG8_SCHED; PG8_LDA(At, 0, 0); PG8_STAGE(PG8_SA(1, 1), a1 + hstepA, voffA);
            PG8_WAIT_V(8); PG8_WAIT_L(0); PG8_BAR; PG8_MMA(0, 0, At, B0); PG8_MMA(0, 1, At, B1); PG8_BAR; PG8_SCHED;
            PG8_LDA(At, 0, 1); PG8_STAGE(PG8_SB(0, 0), b2, voffB); PG8_STAGE(PG8_SB(0, 1), b2 + hstepB, voffB);
            PG8_WAIT_V(6); PG8_WAIT_L(0); PG8_BAR; PG8_MMA(1, 0, At, B0); PG8_SCHED; PG8_STAGE(PG8_SA(0, 0), a2, voffA); PG8_SCHED; PG8_MMA(1, 1, At, B1); PG8_BAR; PG8_SCHED;
            PG8_LDB(B0, 1, 0); PG8_LDB(B1, 1, 1); PG8_SCHED; PG8_LDA(At, 1, 0); PG8_STAGE(PG8_SA(0, 1), a2 + hstepA, voffA);
            PG8_WAIT_V(8); PG8_WAIT_L(0); PG8_BAR; PG8_MMA(0, 0, At, B0); PG8_MMA(0, 1, At, B1); PG8_BAR; PG8_SCHED;
            PG8_LDA(At, 1, 1); PG8_STAGE(PG8_SB(1, 0), b3, voffB); PG8_STAGE(PG8_SB(1, 1), b3 + hstepB, voffB);
            PG8_WAIT_V(6); PG8_WAIT_L(0); PG8_BAR; PG8_MMA(1, 0, At, B0); PG8_SCHED; PG8_STAGE(PG8_SA(1, 0), a3, voffA); PG8_SCHED; PG8_MMA(1, 1, At, B1); PG8_BAR; PG8_SCHED;
            } else {
            PG8_LDB(B0, 0, 0); PG8_SCHED; PG8_LDA(At, 0, 0); PG8_STAGE(PG8_SA(1, 1), a1 + hstepA, voffA);
            PG8_WAIT_L(8); PG8_BAR; PG8_WAIT_L(0); PG8_MMA(0, 0, At, B0); PG8_BAR; PG8_SCHED;
            PG8_LDB(B1, 0, 1); PG8_STAGE(PG8_SB(0, 0), b2, voffB);
            PG8_BAR; PG8_WAIT_L(0); PG8_MMA(0, 1, At, B1); PG8_BAR;
            PG8_LDA(At, 0, 1); PG8_STAGE(PG8_SA(0, 0), a2, voffA);
            PG8_BAR; PG8_WAIT_L(0); PG8_MMA(1, 0, At, B0); PG8_BAR; PG8_SCHED;
            PG8_STAGE(PG8_SB(0, 1), b2 + hstepB, voffB);
            PG8_WAIT_V(6); PG8_BAR; PG8_MMA(1, 1, At, B1); PG8_BAR;
            PG8_LDB(B0, 1, 0); PG8_SCHED; PG8_LDA(At, 1, 0); PG8_STAGE(PG8_SA(0, 1), a2 + hstepA, voffA);
            PG8_WAIT_L(8); PG8_BAR; PG8_WAIT_L(0); PG8_MMA(0, 0, At, B0); PG8_BAR; PG8_SCHED;
            PG8_LDB(B1, 1, 1); PG8_STAGE(PG8_SB(1, 0), b3, voffB);
            PG8_BAR; PG8_WAIT_L(0); PG8_MMA(0, 1, At, B1); PG8_BAR;
            PG8_LDA(At, 1, 1); PG8_STAGE(PG8_SA(1, 0), a3, voffA);
            PG8_BAR; PG8_WAIT_L(0); PG8_MMA(1, 0, At, B0); PG8_BAR; PG8_SCHED;
            PG8_STAGE(PG8_SB(1, 1), b3 + hstepB, voffB);
            PG8_WAIT_V(6); PG8_BAR; PG8_MMA(1, 1, At, B1); PG8_BAR;
            }
        }
        if constexpr (F8) asm volatile("s_nop 15\n\ts_nop 7" ::: "memory");
        if constexpr (ALIGN_EPI) { if (wr == 0) PG8_BAR; }
        if constexpr (!Epi::AFTER_DRAIN) { E(acc, cur, wr, wc, fr, fq); S.done(cur); }
        if (!has_next) break;
#pragma unroll
        for (int a = 0; a < 2; ++a)
#pragma unroll
            for (int b = 0; b < 2; ++b)
#pragma unroll
                for (int m = 0; m < 4; ++m)
#pragma unroll
                    for (int n = 0; n < 2; ++n) acc[a][b][m][n] = (f32x4){0.f, 0.f, 0.f, 0.f};
        cur = nxt; cA = nA; cB = nB; ++ui;
        if constexpr (ALIGN_EPI) { if (wr == 1) PG8_BAR; }
    }
    PG8_WAIT_V(0);
    if constexpr (!ALIGN_EPI) { if (wr == 0) PG8_BAR; }
    PG8_BAR;
    if constexpr (Epi::AFTER_DRAIN) { E.fused(acc, cur, wr, wc, fr, fq, lds, wid, lane); S.done(cur); }
#undef PG8_SA
#undef PG8_SB
#undef PG8_STAGE
#undef PG8_LDA
#undef PG8_LDB
#undef PG8_MMA
#undef PG8_WAIT_V
#undef PG8_WAIT_L
#undef PG8_BAR
#undef PG8_SCHED
}
}

constexpr int NWAVES = 8;
constexpr int BATCH = 4, SEQ = 8192, D = 1024, M = BATCH * SEQ;
constexpr int INW = 3072, C_SBQ = 0, C_SBK = 512, C_SBV = 1024, C_DFQ = 1536, C_DFK = 2048, C_DFV = 2560;
constexpr int GATEW = 2048, DFF = 2816, NEXP = 8, DFE = 3584;
constexpr float NORM_EPS = 1e-6f;
constexpr int MOE_MAX_TILES = 2 * M / 256 + NEXP, MOE_CHUNK_TILES = MOE_MAX_TILES, MOE_MAX_CHUNKS = (MOE_MAX_TILES + MOE_CHUNK_TILES - 1) / MOE_CHUNK_TILES;

constexpr size_t MiB = 1u << 20;
constexpr size_t WS_CTL = 0, CTL_ZERO_BYTES = 1 * MiB;
constexpr size_t WS_WT = 1 * MiB;
constexpr size_t WT_LAYER = 14 * MiB, WT_WIN = 0, WT_WG = 6 * MiB, WT_WSB = 10 * MiB, WT_WDF = 11 * MiB, WT_WOUT = 12 * MiB;
constexpr size_t WS_WGU = 29 * MiB, WS_WDOWN = 40 * MiB;
constexpr size_t WS_MOE13 = 494 * MiB, WS_MOE2 = 206 * MiB;
constexpr size_t MOE13_EXP = 7 * MiB, MOE2_EXP = 7 * MiB / 2;
constexpr size_t WS_FRAG = 46 * MiB;
constexpr size_t WS_H = 174 * MiB;
constexpr size_t WS_Y = 238 * MiB;
constexpr size_t WS_PROJ = 302 * MiB;
constexpr size_t WS_GATES = WS_PROJ, WS_MERGED = WS_PROJ + 128 * MiB, WS_HID = WS_PROJ;
constexpr size_t WS_XS = 1 * MiB;
constexpr size_t WS_YS = 67 * MiB;
constexpr size_t WS_HIDC = 238 * MiB;
constexpr size_t WS_LTOK = 234 * MiB, WS_LW = 235 * MiB, WS_STOK = 236 * MiB, WS_SW = 236 * MiB + 512 * 1024;
constexpr size_t WS_SA = 237 * MiB, WS_PMAX = 237 * MiB + 256 * 1024, WS_SWC = 237 * MiB + 832 * 1024;
constexpr size_t WS_END = 550 * MiB;
static_assert(WS_WDOWN + (size_t)D * DFF * 2 <= WS_FRAG && WS_H + (size_t)M * D <= WS_MOE2 && WS_MOE2 + 8 * MOE2_EXP <= WS_LTOK && WS_SWC + 15872 * 4 <= WS_Y && WS_PROJ + (size_t)M * INW * 2 <= WS_MOE13 && WS_MOE13 + 8 * MOE13_EXP <= WS_END, "ws map");
static_assert(WS_XS + (size_t)MOE_MAX_TILES * 256 * D <= WS_YS && WS_YS + (size_t)MOE_MAX_TILES * 256 * D * 2 <= WS_MOE2 && WS_HIDC + (size_t)MOE_CHUNK_TILES * 256 * DFE <= WS_MOE13 && WS_HID + (size_t)M * DFF * 2 <= WS_MOE13 && (size_t)MOE_MAX_TILES * 256 * 4 <= 512 * 1024, "ws map 2");
constexpr float SC_W13 = 64.f, SC_W2 = 128.f;
constexpr int CW_BAR = 4096;
constexpr int CW_WMAX = 10240;
constexpr int CW_CNT = 8192;

constexpr int RING_OFF = 0, RING_BYTES = 131072;
constexpr int LDSCTL_OFF = RING_BYTES, MISC_OFF = LDSCTL_OFF + 320, PLAN_OFF = LDSCTL_OFF + 1024;
constexpr int LDS_BYTES = 147456;

#define GAS __attribute__((address_space(1)))
#define LAS __attribute__((address_space(3)))
typedef unsigned short bf16;
typedef unsigned v4u __attribute__((ext_vector_type(4)));
typedef unsigned v2u __attribute__((ext_vector_type(2)));
typedef float f32x4 __attribute__((ext_vector_type(4)));
typedef GAS unsigned gu32;
#define RLX_AGENT __ATOMIC_RELAXED, __HIP_MEMORY_SCOPE_AGENT
#define LDS_WAIT() asm volatile("s_waitcnt lgkmcnt(0)" ::: "memory")
#define VM_WAIT() asm volatile("s_waitcnt vmcnt(0)" ::: "memory")
__device__ __forceinline__ unsigned f2bf(float f) { unsigned u = __builtin_bit_cast(unsigned, f); return (u + 0x7fffu + ((u >> 16) & 1u)) >> 16; }
__device__ __forceinline__ unsigned pk2(float lo, float hi) { return f2bf(lo) | (f2bf(hi) << 16); }
__device__ __forceinline__ float bflo(unsigned w) { return __uint_as_float(w << 16); }
__device__ __forceinline__ float bfhi(unsigned w) { return __uint_as_float(w & 0xffff0000u); }
__device__ __forceinline__ float bf2f(bf16 b) { return __uint_as_float((unsigned)b << 16); }
#define XB_TMO      128
#define XB_XCNT(j)  (256  + 64 * (j))
#define XB_XSUB(j)  (1280 + 64 * (j))
#define XB_XGEN(j)  (2304 + 64 * (j))
#define XB_TOP      3328
#define XB_TOPGEN   3392
#define XCD_BAR_WORDS 3456
#define XB_SPIN_CAP (1u << 18)

__device__ __forceinline__ unsigned xb_ld(unsigned* p)              { return __hip_atomic_load(p, __ATOMIC_RELAXED, __HIP_MEMORY_SCOPE_AGENT); }
__device__ __forceinline__ unsigned xb_add(unsigned* p, unsigned v) { return __hip_atomic_fetch_add(p, v, __ATOMIC_RELAXED, __HIP_MEMORY_SCOPE_AGENT); }
__device__ __forceinline__ unsigned xb_xcc_id() { return (unsigned)__builtin_amdgcn_s_getreg((3 << 11) | 20) & 0xFu; }
#define XB_SPIN(cond, bar) do { unsigned _sp = 0; while (cond) { __builtin_amdgcn_s_sleep(1); \
    if ((++_sp & 255u) == 0u) { if (xb_ld(&(bar)[XB_TMO])) break; if (_sp > XB_SPIN_CAP) { atomicAdd(&(bar)[XB_TMO], 1u); break; } } } } while (0)

struct XcdBarrier {
    unsigned* bar; unsigned x;
    volatile LAS unsigned* st;
};

__device__ __forceinline__ XcdBarrier xcd_barrier_post(unsigned* bar, volatile LAS unsigned* st) {
    XcdBarrier b; b.bar = bar; b.x = xb_xcc_id(); b.st = st;
    if (cur_tid() == 0) (void)xb_add(&bar[XB_XCNT(b.x)], 1u);
    return b;
}
__device__ __forceinline__ void xcd_barrier_complete(unsigned* bar, unsigned x, unsigned& nloc, unsigned& nx) {
    const unsigned G = gridDim.x * gridDim.y * gridDim.z;
    unsigned sum, cnt, mine, sp = 0u;
    for (;;) {
        sum = 0u; cnt = 0u; mine = 0u;
#pragma unroll
        for (unsigned j = 0; j < 16; ++j) { const unsigned c = xb_ld(&bar[XB_XCNT(j)]); sum += c; cnt += (c > 0u) ? 1u : 0u; mine = (j == x) ? c : mine; }
        if (sum == G) break;
        __builtin_amdgcn_s_sleep(1);
        if ((++sp & 255u) == 0u) { if (xb_ld(&bar[XB_TMO])) break; if (sp > XB_SPIN_CAP) { atomicAdd(&bar[XB_TMO], 1u); break; } }
    }
    nloc = mine > 0u ? mine : 1u; nx = cnt > 0u ? cnt : 1u;
}

__device__ __forceinline__ void xcd_barrier(const XcdBarrier& b) {
    asm volatile("s_waitcnt vmcnt(0)" ::: "memory");
    __syncthreads();
    if (cur_tid() == 0) {
        unsigned* bar = b.bar;
        __builtin_amdgcn_s_waitcnt(0);
        unsigned nloc = b.st[0], nx = b.st[1];
        if (nloc == 0u) { xcd_barrier_complete(bar, b.x, nloc, nx); b.st[0] = nloc; b.st[1] = nx; }
        const unsigned old = xb_add(&bar[XB_XSUB(b.x)], 1u);
        const unsigned gen = old / nloc;
        if (old + 1u == (gen + 1u) * nloc) {
            __builtin_amdgcn_fence(__ATOMIC_RELEASE, "agent");
            asm volatile("s_waitcnt vmcnt(0)" ::: "memory");
            const unsigned og = xb_add(&bar[XB_TOP], 1u);
            const unsigned tg = og / nx;
            if (og + 1u == (tg + 1u) * nx) xb_add(&bar[XB_TOPGEN], 1u);
            else XB_SPIN(xb_ld(&bar[XB_TOPGEN]) == tg, bar);
            __builtin_amdgcn_fence(__ATOMIC_ACQUIRE, "agent");
            xb_add(&bar[XB_XGEN(b.x)], 1u);
            asm volatile("s_waitcnt vmcnt(0)" ::: "memory");
        } else {
            XB_SPIN(xb_ld(&bar[XB_XGEN(b.x)]) == gen, bar);
            __builtin_amdgcn_fence(__ATOMIC_ACQUIRE, "agent");
            asm volatile("s_waitcnt vmcnt(0)" ::: "memory");
        }
    }
    __syncthreads();
}

struct Frame {
    LAS unsigned char* lds;
    volatile LAS unsigned* MISC;
    gu32* ctl;
    int tid, lane, wave;
    int vcu, G;
    unsigned char* ws;
    typedef const float* cfptr_t;
    const __attribute__((address_space(4))) cfptr_t* in;
    float* out;
};
__device__ __forceinline__ float wave_sum(float v) {
#pragma unroll
    for (int o = 1; o < 64; o <<= 1) v += __shfl_xor(v, o);
    return v;
}
__device__ __forceinline__ float wave_max(float v) {
#pragma unroll
    for (int o = 1; o < 64; o <<= 1) v = fmaxf(v, __shfl_xor(v, o));
    return v;
}
__device__ __forceinline__ void transpose_item(const float* W, int K, int N, bf16* WT, int imode, LAS float* scr, int item, int lane) {
    const int nblk = N / 32, kb = item / nblk, nb = item % nblk, k0 = 64 * kb, n0 = 32 * nb;
    int drow = n0;
    if (imode != 0) { int j = n0, half = (imode == 2) ? 1 : 0; if (imode == 3) { const int hn = N / 2; if (n0 >= hn) { j = n0 - hn; half = 1; } } drow = (j / 128) * 256 + half * 128 + (j % 128); }
#pragma unroll 8
    for (int i = 0; i < 32; ++i) { const int kk = 2 * i + (lane >> 5); scr[kk * 33 + (lane & 31)] = W[(size_t)(k0 + kk) * N + n0 + (lane & 31)]; }
    LDS_WAIT(); asm volatile("" ::: "memory");
    const int c = lane & 7;
#pragma unroll
    for (int j = 0; j < 4; ++j) { const int n = (lane >> 3) + 8 * j; const LAS float* s = scr + (8 * c) * 33 + n;
        v4u o; o.x = pk2(s[0 * 33], s[1 * 33]); o.y = pk2(s[2 * 33], s[3 * 33]); o.z = pk2(s[4 * 33], s[5 * 33]); o.w = pk2(s[6 * 33], s[7 * 33]);
        *(GAS v4u*)(WT + (size_t)(drow + n) * K + k0 + 8 * c) = o; }
    LDS_WAIT(); asm volatile("" ::: "memory");
}
__device__ __forceinline__ void transpose_item8(const float* W, int K, int N, unsigned char* WT, int imode, float scale, LAS float* scr, int item, int lane) {
    const int nblk = N / 32, kb = item / nblk, nb = item % nblk, k0 = 64 * kb, n0 = 32 * nb;
    int drow = n0;
    if (imode != 0) { int j = n0, half = (imode == 2) ? 1 : 0; if (imode == 3) { const int hn = N / 2; if (n0 >= hn) { j = n0 - hn; half = 1; } } drow = (j / 128) * 256 + half * 128 + (j % 128); }
#pragma unroll 8
    for (int i = 0; i < 32; ++i) { const int kk = 2 * i + (lane >> 5); scr[kk * 33 + (lane & 31)] = __builtin_nontemporal_load(W + (size_t)(k0 + kk) * N + n0 + (lane & 31)); }
    LDS_WAIT(); asm volatile("" ::: "memory");
    const int c = lane & 7;
#pragma unroll
    for (int j = 0; j < 4; ++j) { const int n = (lane >> 3) + 8 * j; const LAS float* s = scr + (8 * c) * 33 + n;
        v2u o; o.x = pg8::pack4_f8(s[0 * 33] * scale, s[1 * 33] * scale, s[2 * 33] * scale, s[3 * 33] * scale); o.y = pg8::pack4_f8(s[4 * 33] * scale, s[5 * 33] * scale, s[6 * 33] * scale, s[7 * 33] * scale);
        *(GAS v2u*)(WT + (size_t)(drow + n) * K + k0 + 8 * c) = o; }
    LDS_WAIT(); asm volatile("" ::: "memory");
}
constexpr int XLD = 2 * D;
template <bool XBF> __device__ __forceinline__ f32x4 ld_x4(const void* xrow, int lane, int j) {
    if (XBF) { const v2u w = ((const GAS v2u*)xrow)[lane + 64 * j]; return (f32x4){bflo(w.x), bfhi(w.x), bflo(w.y), bfhi(w.y)}; }
    return ((const GAS f32x4*)xrow)[lane + 64 * j];
}
template <bool OUT8 = false, bool XBF = false> __device__ __forceinline__ void rms_row(const void* xrow, const float* g, bf16* orow, int lane, f32x4 (&hv)[4]) {
    const GAS f32x4* gr = (const GAS f32x4*)g + lane;
    f32x4 v[4]; float s = 0.f;
#pragma unroll
    for (int j = 0; j < 4; ++j) { v[j] = ld_x4<XBF>(xrow, lane, j); s += (v[j].x * v[j].x + v[j].y * v[j].y) + (v[j].z * v[j].z + v[j].w * v[j].w); }
    const float rstd = rsqrtf(wave_sum(s) * (1.f / D) + NORM_EPS);
    GAS unsigned long long* o8 = (GAS unsigned long long*)orow + lane; GAS unsigned* o4 = (GAS unsigned*)orow + lane;
#pragma unroll
    for (int j = 0; j < 4; ++j) { const f32x4 gg = gr[64 * j]; const f32x4 h = v[j] * rstd * gg; hv[j] = h;
        if (OUT8) o4[64 * j] = pg8::pack4_f8(h.x, h.y, h.z, h.w);
        else o8[64 * j] = (unsigned long long)pk2(h.x, h.y) | ((unsigned long long)pk2(h.z, h.w) << 32); }
}
__device__ __forceinline__ void rms_row_i8(f32x4 (&v)[4], const f32x4 (&gg)[4], unsigned char* orow, float* sa, int lane) {
    float s = 0.f;
#pragma unroll
    for (int j = 0; j < 4; ++j) s += (v[j].x * v[j].x + v[j].y * v[j].y) + (v[j].z * v[j].z + v[j].w * v[j].w);
    const float rstd = rsqrtf(wave_sum(s) * (1.f / D) + NORM_EPS); float am = 0.f;
#pragma unroll
    for (int j = 0; j < 4; ++j) { v[j] = v[j] * rstd * gg[j]; am = fmaxf(fmaxf(am, fmaxf(fabsf(v[j].x), fabsf(v[j].y))), fmaxf(fabsf(v[j].z), fabsf(v[j].w))); }
    am = fmaxf(wave_max(am), 1e-30f); const float inv = 127.f / am;
    GAS unsigned* o4 = (GAS unsigned*)orow + lane;
#pragma unroll
    for (int j = 0; j < 4; ++j) o4[64 * j] = pg8::pack4_i8(v[j].x * inv, v[j].y * inv, v[j].z * inv, v[j].w * inv);
    if (lane == 0) *sa = am * (1.f / 127.f);
}
template <bool XBF> __device__ __forceinline__ void norm_rows_i8(Frame& F, const void* x, const float* g, unsigned char* H8, float* SA) {
    const int gw = F.vcu * NWAVES + F.wave, NGW = F.G * NWAVES, lane = F.lane;
    f32x4 gg[4], cur[4], nxt[4];
#pragma unroll
    for (int j = 0; j < 4; ++j) { gg[j] = ((const GAS f32x4*)g)[lane + 64 * j]; cur[j] = (f32x4){0.f, 0.f, 0.f, 0.f}; nxt[j] = cur[j]; }
#define NR_ROW(m_) (XBF ? (const void*)((const bf16*)x + (size_t)(m_) * XLD) : (const void*)((const float*)x + (size_t)(m_) * D))
    if (gw < M) {
#pragma unroll
        for (int j = 0; j < 4; ++j) cur[j] = ld_x4<XBF>(NR_ROW(gw), lane, j); }
    for (int m = gw; m < M; m += NGW) {
        const int mn = m + NGW;
        if (mn < M) {
#pragma unroll
            for (int j = 0; j < 4; ++j) nxt[j] = ld_x4<XBF>(NR_ROW(mn), lane, j); }
        rms_row_i8(cur, gg, H8 + (size_t)m * D, SA + m, lane);
#pragma unroll
        for (int j = 0; j < 4; ++j) cur[j] = nxt[j];
    }
#undef NR_ROW
}
constexpr int WQ_NCOL = 2 * (INW + GATEW) + 2 * DFF;
__device__ __forceinline__ int wq_coff(int t) { return t == 4 ? 2 * (INW + GATEW) : (t >> 1) * (INW + GATEW) + (t & 1) * INW; }
__device__ __forceinline__ const float* wq_tensor(Frame& F, int t, int& N) {
    if (t == 4) { N = 2 * DFF; return F.in[13]; }
    const int L = t >> 1; if (t & 1) { N = GATEW; return F.in[7] + (size_t)L * D * GATEW; } N = INW; return F.in[2] + (size_t)L * D * INW;
}
__device__ __forceinline__ void wcolmax_partials(Frame& F, float* pcm) {
    const int gw = F.vcu * NWAVES + F.wave, NGW = F.G * NWAVES;
    constexpr int NB = WQ_NCOL / 256;
    for (int it = gw; it < NB * 8; it += NGW) {
        const int ke = it & 7, cbg = it >> 3;
        int t = 0, cb = cbg;
        { const int nb[5] = {INW / 256, GATEW / 256, INW / 256, GATEW / 256, 2 * DFF / 256};
#pragma unroll
          for (int i = 0; i < 4; ++i) if (t == i && cb >= nb[i]) { cb -= nb[i]; t = i + 1; } }
        int N; const float* W = wq_tensor(F, t, N);
        const GAS f32x4* p = (const GAS f32x4*)(W + (size_t)(128 * ke) * N + 256 * cb) + F.lane;
        f32x4 m = (f32x4){0.f, 0.f, 0.f, 0.f};
#pragma unroll 8
        for (int k = 0; k < 128; ++k) { const f32x4 v = p[(size_t)k * (N / 4)]; m.x = fmaxf(m.x, fabsf(v.x)); m.y = fmaxf(m.y, fabsf(v.y)); m.z = fmaxf(m.z, fabsf(v.z)); m.w = fmaxf(m.w, fabsf(v.w)); }
        *((GAS f32x4*)(pcm + (size_t)ke * WQ_NCOL + wq_coff(t) + 256 * cb) + F.lane) = m;
    }
}
__device__ __forceinline__ void transpose_item_i8(const float* W, int K, int N, unsigned char* WT, int imode, const float* pcm, float* swc, LAS float* scr, int item, int lane) {
    const int nblk = N / 32, kb = item / nblk, nb = item % nblk, k0 = 64 * kb, n0 = 32 * nb;
    int drow = n0;
    if (imode != 0) { int j = n0, half = (imode == 2) ? 1 : 0; if (imode == 3) { const int hn = N / 2; if (n0 >= hn) { j = n0 - hn; half = 1; } } drow = (j / 128) * 256 + half * 128 + (j % 128); }
    float cm = 1e-30f;
#pragma unroll
    for (int ke = 0; ke < 8; ++ke) cm = fmaxf(cm, pcm[(size_t)ke * WQ_NCOL + n0 + (lane & 31)]);
    const float cinv = 127.f / cm;
    if (kb == 0 && lane < 32) swc[n0 + lane] = cm * (1.f / 127.f);
#pragma unroll 8
    for (int i = 0; i < 32; ++i) { const int kk = 2 * i + (lane >> 5); scr[kk * 33 + (lane & 31)] = W[(size_t)(k0 + kk) * N + n0 + (lane & 31)]; }
    LDS_WAIT(); asm volatile("" ::: "memory");
    const int c = lane & 7;
#pragma unroll
    for (int j = 0; j < 4; ++j) { const int n = (lane >> 3) + 8 * j; const LAS float* s = scr + (8 * c) * 33 + n;
        const float scale = __shfl(cinv, n);
        v2u o; o.x = pg8::pack4_i8(s[0 * 33] * scale, s[1 * 33] * scale, s[2 * 33] * scale, s[3 * 33] * scale); o.y = pg8::pack4_i8(s[4 * 33] * scale, s[5 * 33] * scale, s[6 * 33] * scale, s[7 * 33] * scale);
        *(GAS v2u*)(WT + (size_t)(drow + n) * K + k0 + 8 * c) = o; }
    LDS_WAIT(); asm volatile("" ::: "memory");
}
template <bool OUT8 = false> __device__ __forceinline__ void norm_rows(Frame& F, const float* x, const float* g, bf16* H) {
    const int gw = F.vcu * NWAVES + F.wave, NGW = F.G * NWAVES;
    for (int m = gw; m < M; m += NGW) { f32x4 hv[4]; rms_row<OUT8>(x + (size_t)m * D, g, OUT8 ? (bf16*)((unsigned char*)H + (size_t)m * D) : H + (size_t)m * D, F.lane, hv); }
}
__device__ __forceinline__ void convert_small_weights(Frame& F) {
    LAS float* scr = (LAS float*)(F.lds + RING_OFF + F.wave * 16384); const float* PCM = (const float*)(F.ws + WS_PMAX); float* SWC = (float*)(F.ws + WS_SWC);
    const int gw = F.vcu * NWAVES + F.wave, NGW = F.G * NWAVES;
    constexpr int I_IN = (D / 64) * (INW / 32), I_G = (D / 64) * (GATEW / 32), I_B = (512 / 64) * (D / 32), I_O = (D / 64) * (D / 32), I_L = I_IN + I_G + 2 * I_B + I_O;
    constexpr int I_GU = (D / 64) * (2 * DFF / 32), I_DN = (DFF / 64) * (D / 32), NITEMS = 2 * I_L + I_GU + I_DN;
    for (int it = gw; it < NITEMS; it += NGW) {
        int r = it;
        if (r < 2 * I_L) { const int L = r / I_L; r -= L * I_L; bf16* wt = (bf16*)(F.ws + WS_WT + (size_t)L * WT_LAYER);
            if (r < I_IN) { transpose_item_i8(F.in[2] + (size_t)L * D * INW, D, INW, (unsigned char*)wt + WT_WIN, 0, PCM + wq_coff(2 * L), SWC + wq_coff(2 * L), scr, r, F.lane); continue; } r -= I_IN;
            if (r < I_G) { transpose_item_i8(F.in[7] + (size_t)L * D * GATEW, D, GATEW, (unsigned char*)wt + WT_WG, 0, PCM + wq_coff(2 * L + 1), SWC + wq_coff(2 * L + 1), scr, r, F.lane); continue; } r -= I_G;
            if (r < I_B) { transpose_item(F.in[9] + (size_t)L * 512 * D, 512, D, (bf16*)((unsigned char*)wt + WT_WSB), 0, scr, r, F.lane); continue; } r -= I_B;
            if (r < I_B) { transpose_item(F.in[10] + (size_t)L * 512 * D, 512, D, (bf16*)((unsigned char*)wt + WT_WDF), 0, scr, r, F.lane); continue; } r -= I_B;
            transpose_item(F.in[11] + (size_t)L * D * D, D, D, (bf16*)((unsigned char*)wt + WT_WOUT), 0, scr, r, F.lane); continue; }
        r -= 2 * I_L;
        if (r < I_GU) { transpose_item_i8(F.in[13], D, 2 * DFF, F.ws + WS_WGU, 3, PCM + wq_coff(4), SWC + wq_coff(4), scr, r, F.lane); continue; } r -= I_GU;
        transpose_item(F.in[14], DFF, D, (bf16*)(F.ws + WS_WDOWN), 0, scr, r, F.lane);
    }
}
constexpr int CV_ITEMS = 56, CV_UNITS = NEXP * (2 * (D / 64) * (DFE / 32) + (DFE / 64) * (D / 32)) / CV_ITEMS;
static_assert(CV_UNITS * CV_ITEMS == NEXP * (2 * (D / 64) * (DFE / 32) + (DFE / 64) * (D / 32)) && CV_ITEMS % NWAVES == 0, "conversion units");
struct CvItem { const float* src; unsigned char* dst; int N, K; float scale; int bf; };
constexpr int CVB_SB = (512 / 64) * (D / 32), CVB_O = (D / 64) * (D / 32), CVB_L = 2 * CVB_SB + CVB_O, CVB_DN = (DFF / 64) * (D / 32), CVB_ITEMS = 2 * CVB_L + CVB_DN;
__device__ __forceinline__ CvItem cv_decode_bf16(const Frame& F, int it) {
    CvItem c; c.scale = 1.f; c.bf = 1; c.N = D; const float* W; unsigned char* WT; int r = it;
    if (r < 2 * CVB_L) { const int L = r / CVB_L; r -= L * CVB_L; unsigned char* wt = F.ws + WS_WT + (size_t)L * WT_LAYER;
        if (r < CVB_SB) { W = F.in[9] + (size_t)L * 512 * D; c.K = 512; WT = wt + WT_WSB; }
        else if (r < 2 * CVB_SB) { r -= CVB_SB; W = F.in[10] + (size_t)L * 512 * D; c.K = 512; WT = wt + WT_WDF; }
        else { r -= 2 * CVB_SB; W = F.in[11] + (size_t)L * D * D; c.K = D; WT = wt + WT_WOUT; } }
    else { r -= 2 * CVB_L; W = F.in[14]; c.K = DFF; WT = F.ws + WS_WDOWN; c.bf = 0; c.scale = SC_W2; }
    const int nblk = D / 32, kb = r / nblk, nb = r - kb * nblk, k0 = 64 * kb, n0 = 32 * nb;
    c.src = W + (size_t)k0 * D + n0; c.dst = WT + ((size_t)n0 * c.K + k0) * (c.bf ? 2 : 1); return c;
}
__device__ __forceinline__ CvItem cv_decode(const Frame& F, int it) {
    constexpr int I_1 = (D / 64) * (DFE / 32), I_2 = (DFE / 64) * (D / 32), I_E = 2 * I_1 + I_2;
    const int e = it / I_E; int r = it - e * I_E; CvItem c; c.bf = 0;
    const float* W; unsigned char* WT; int imode;
    if (r < I_1) { W = F.in[16] + (size_t)e * D * DFE; c.K = D; c.N = DFE; WT = F.ws + WS_MOE13 + (size_t)e * MOE13_EXP; imode = 1; c.scale = SC_W13; }
    else if (r < 2 * I_1) { r -= I_1; W = F.in[17] + (size_t)e * D * DFE; c.K = D; c.N = DFE; WT = F.ws + WS_MOE13 + (size_t)e * MOE13_EXP; imode = 2; c.scale = SC_W13; }
    else { r -= 2 * I_1; W = F.in[18] + (size_t)e * DFE * D; c.K = DFE; c.N = D; WT = F.ws + WS_MOE2 + (size_t)e * MOE2_EXP; imode = 0; c.scale = SC_W2; }
    const int nblk = c.N / 32, kb = r / nblk, nb = r - kb * nblk, k0 = 64 * kb, n0 = 32 * nb;
    const int drow = (imode == 0) ? n0 : (n0 / 128) * 256 + (imode - 1) * 128 + (n0 % 128);
    c.src = W + (size_t)k0 * c.N + n0; c.dst = WT + (size_t)drow * c.K + k0; return c;
}
__device__ __forceinline__ void cv_load(const CvItem& c, int lane, f32x4 (&v)[8]) {
    const float* p = c.src + (size_t)(lane >> 3) * c.N + 4 * (lane & 7);
#pragma unroll
    for (int j = 0; j < 8; ++j) v[j] = __builtin_nontemporal_load((const f32x4*)(p + (size_t)(8 * j) * c.N));
}
__device__ __forceinline__ void cv_store(const CvItem& c, int lane, const f32x4 (&v)[8], LAS float* scr) {
#pragma unroll
    for (int j = 0; j < 8; ++j) { LAS float* d = scr + (8 * j + (lane >> 3)) * 33 + 4 * (lane & 7); d[0] = v[j].x; d[1] = v[j].y; d[2] = v[j].z; d[3] = v[j].w; }
    LDS_WAIT(); asm volatile("" ::: "memory");
    const int cc = lane & 7; const float scale = c.scale;
    if (c.bf) {
#pragma unroll
        for (int j = 0; j < 4; ++j) { const int n = (lane >> 3) + 8 * j; const LAS float* s = scr + (8 * cc) * 33 + n;
            v4u o; o.x = pk2(s[0 * 33], s[1 * 33]); o.y = pk2(s[2 * 33], s[3 * 33]); o.z = pk2(s[4 * 33], s[5 * 33]); o.w = pk2(s[6 * 33], s[7 * 33]);
            *(GAS v4u*)(c.dst + ((size_t)n * c.K + 8 * cc) * 2) = o; }
    } else {
#pragma unroll
        for (int j = 0; j < 4; ++j) { const int n = (lane >> 3) + 8 * j; const LAS float* s = scr + (8 * cc) * 33 + n;
            v2u o; o.x = pg8::pack4_f8(s[0 * 33] * scale, s[1 * 33] * scale, s[2 * 33] * scale, s[3 * 33] * scale); o.y = pg8::pack4_f8(s[4 * 33] * scale, s[5 * 33] * scale, s[6 * 33] * scale, s[7 * 33] * scale);
            *(GAS v2u*)(c.dst + (size_t)n * c.K + 8 * cc) = o; }
    }
    LDS_WAIT(); asm volatile("" ::: "memory");
}
template <bool BF> __device__ __forceinline__ void convert_item_unit(Frame& F, int unit) {
    LAS float* scr = (LAS float*)(F.lds + RING_OFF + F.wave * 9216);
    const int it0 = unit * CV_ITEMS + F.wave * (CV_ITEMS / NWAVES);
    constexpr int NIT = CV_ITEMS / NWAVES, LIM = BF ? CVB_ITEMS : 0x7fffffff;
    f32x4 va[8], vb[8];
    CvItem ca, cb;
    if (it0 < LIM) { ca = BF ? cv_decode_bf16(F, it0) : cv_decode(F, it0); cv_load(ca, F.lane, va); }
#pragma unroll
    for (int i = 0; i < NIT; i += 2) {
        if (i + 1 < NIT && it0 + i + 1 < LIM) { cb = BF ? cv_decode_bf16(F, it0 + i + 1) : cv_decode(F, it0 + i + 1); cv_load(cb, F.lane, vb); }
        if (it0 + i < LIM) cv_store(ca, F.lane, va, scr);
        if (i + 1 < NIT) {
            if (i + 2 < NIT && it0 + i + 2 < LIM) { ca = BF ? cv_decode_bf16(F, it0 + i + 2) : cv_decode(F, it0 + i + 2); cv_load(ca, F.lane, va); }
            if (it0 + i + 1 < LIM) cv_store(cb, F.lane, vb, scr);
        }
    }
}
__device__ __forceinline__ void convert_i8_colblock(Frame& F, const float* W, int N, unsigned char* WT, int imode, float* swc, int nb) {
    const int lane = F.lane, w = F.wave, n0 = 32 * nb;
    int drow = n0;
    if (imode == 3) { const int hn = N / 2; int j = n0, half = 0; if (n0 >= hn) { j = n0 - hn; half = 1; } drow = (j / 128) * 256 + half * 128 + (j % 128); }
    LAS float* scr = (LAS float*)(F.lds + RING_OFF + w * 9216); LAS float* CMX = (LAS float*)(F.lds + RING_OFF + NWAVES * 9216);
    const float* p = W + (size_t)(128 * w + (lane >> 3)) * N + n0 + 4 * (lane & 7);
    f32x4 v[16]; f32x4 m = (f32x4){0.f, 0.f, 0.f, 0.f};
#pragma unroll
    for (int j = 0; j < 16; ++j) v[j] = __builtin_nontemporal_load((const f32x4*)(p + (size_t)(8 * j) * N));
#pragma unroll
    for (int j = 0; j < 16; ++j) { m.x = fmaxf(m.x, fabsf(v[j].x)); m.y = fmaxf(m.y, fabsf(v[j].y)); m.z = fmaxf(m.z, fabsf(v[j].z)); m.w = fmaxf(m.w, fabsf(v[j].w)); }
#pragma unroll
    for (int o = 8; o < 64; o <<= 1) { m.x = fmaxf(m.x, __shfl_xor(m.x, o)); m.y = fmaxf(m.y, __shfl_xor(m.y, o)); m.z = fmaxf(m.z, __shfl_xor(m.z, o)); m.w = fmaxf(m.w, __shfl_xor(m.w, o)); }
    if (lane < 8) { LAS float* d = CMX + w * 32 + 4 * lane; d[0] = m.x; d[1] = m.y; d[2] = m.z; d[3] = m.w; }
    __syncthreads();
    float cm = 1e-30f;
#pragma unroll
    for (int ke = 0; ke < NWAVES; ++ke) cm = fmaxf(cm, CMX[ke * 32 + (lane & 31)]);
    const float cinv = 127.f / cm;
    if (w == 0 && lane < 32) swc[n0 + lane] = cm * (1.f / 127.f);
    const int c = lane & 7;
#pragma unroll
    for (int hf = 0; hf < 2; ++hf) {
#pragma unroll
        for (int j = 0; j < 8; ++j) { LAS float* d = scr + (8 * j + (lane >> 3)) * 33 + 4 * c; const f32x4 x = v[8 * hf + j]; d[0] = x.x; d[1] = x.y; d[2] = x.z; d[3] = x.w; }
        LDS_WAIT(); asm volatile("" ::: "memory");
        const int k0 = 128 * w + 64 * hf;
#pragma unroll
        for (int j = 0; j < 4; ++j) { const int n = (lane >> 3) + 8 * j; const LAS float* s = scr + (8 * c) * 33 + n;
            const float scale = __shfl(cinv, n);
            v2u o; o.x = pg8::pack4_i8(s[0 * 33] * scale, s[1 * 33] * scale, s[2 * 33] * scale, s[3 * 33] * scale); o.y = pg8::pack4_i8(s[4 * 33] * scale, s[5 * 33] * scale, s[6 * 33] * scale, s[7 * 33] * scale);
            *(GAS v2u*)(WT + (size_t)(drow + n) * D + k0 + 8 * c) = o; }
        LDS_WAIT(); asm volatile("" ::: "memory");
    }
    __syncthreads();
}
constexpr int CVQ_I8 = GATEW / 32 + INW / 32 + GATEW / 32 + 2 * DFF / 32, CVQ_BF = (CVB_ITEMS + CV_ITEMS - 1) / CV_ITEMS, CVQ_ALL = CVQ_I8 + CVQ_BF + CV_UNITS;
__device__ __forceinline__ void convert_queue_unit(Frame& F, int cv) {
    float* SWC = (float*)(F.ws + WS_SWC);
    if (cv < CVQ_I8) {
        int q = cv;
        if (q < GATEW / 32) { convert_i8_colblock(F, F.in[7], GATEW, F.ws + WS_WT + WT_WG, 0, SWC + wq_coff(1), q); return; } q -= GATEW / 32;
        if (q < INW / 32) { convert_i8_colblock(F, F.in[2] + (size_t)D * INW, INW, F.ws + WS_WT + WT_LAYER + WT_WIN, 0, SWC + wq_coff(2), q); return; } q -= INW / 32;
        if (q < GATEW / 32) { convert_i8_colblock(F, F.in[7] + (size_t)D * GATEW, GATEW, F.ws + WS_WT + WT_LAYER + WT_WG, 0, SWC + wq_coff(3), q); return; } q -= GATEW / 32;
        convert_i8_colblock(F, F.in[13], 2 * DFF, F.ws + WS_WGU, 3, SWC + wq_coff(4), q); return;
    }
    cv -= CVQ_I8;
    if (cv < CVQ_BF) { convert_item_unit<true>(F, cv); return; }
    convert_item_unit<false>(F, cv - CVQ_BF);
}
__device__ __forceinline__ void norm_route_rows(Frame& F, const bf16* x, const float* g, bf16* H, const float* wr, int* ltok, float* lw, int* tpos) {
    LAS float* WRT = (LAS float*)(F.lds + RING_OFF);
    LAS unsigned* LCNT = (LAS unsigned*)(F.lds + RING_OFF + 32768);
    LAS unsigned* LBASE = LCNT + 8;
    LAS unsigned* REC_E = (LAS unsigned*)(F.lds + RING_OFF + 33024);
    const int RPW = (M + F.G - 1) / F.G;
    LAS unsigned* REC_P0 = REC_E + 1024; LAS unsigned* REC_P1 = REC_P0 + 1024; LAS float* REC_W = (LAS float*)(REC_P1 + 1024);
    for (int i = F.tid; i < 8192; i += NWAVES * 64) WRT[(i & 7) * 1024 + (i >> 3)] = wr[i];
    if (F.tid < 16) LCNT[F.tid] = 0u;
    __syncthreads();
    const int row0 = (int)blockIdx.x * RPW;
    for (int r = F.wave; r < RPW; r += NWAVES) {
        const int m = row0 + r; if (m >= M) break;
        f32x4 hv[4]; rms_row<true, true>(x + (size_t)m * XLD, g, (bf16*)((unsigned char*)H + (size_t)m * D), F.lane, hv);
        float lg[8];
#pragma unroll
        for (int e = 0; e < 8; ++e) { float s = 0.f;
#pragma unroll
            for (int j = 0; j < 4; ++j) { const f32x4 w = *(const LAS f32x4*)(WRT + e * 1024 + 256 * j + 4 * F.lane); s += (hv[j].x * w.x + hv[j].y * w.y) + (hv[j].z * w.z + hv[j].w * w.w); }
            lg[e] = wave_sum(s); }
        int e0 = 0; float b0 = lg[0];
#pragma unroll
        for (int e = 1; e < 8; ++e) if (lg[e] > b0) { b0 = lg[e]; e0 = e; }
        int e1 = -1; float b1 = -INFINITY;
#pragma unroll
        for (int e = 0; e < 8; ++e) if (e != e0 && lg[e] > b1) { b1 = lg[e]; e1 = e; }
        if (F.lane == 0) {
            const float w0 = 1.f / (1.f + __expf(b1 - b0));
            REC_E[r] = (unsigned)e0 | ((unsigned)e1 << 8); REC_W[r] = w0;
            REC_P0[r] = atomicAdd((unsigned*)&LCNT[e0], 1u); REC_P1[r] = atomicAdd((unsigned*)&LCNT[e1], 1u);
        }
    }
    __syncthreads();
    if (F.tid < 8) LBASE[F.tid] = __hip_atomic_fetch_add((unsigned*)(F.ctl + CW_CNT + 64 * F.tid), LCNT[F.tid], RLX_AGENT);
    __syncthreads();
    for (int r = F.tid; r < RPW; r += NWAVES * 64) {
        const int m = row0 + r; if (m >= M) break;
        const unsigned ee = REC_E[r]; const int e0 = ee & 0xff, e1 = ee >> 8; const float w0 = REC_W[r];
        const unsigned p0 = LBASE[e0] + REC_P0[r], p1 = LBASE[e1] + REC_P1[r];
        ltok[(size_t)e0 * M + p0] = m; lw[(size_t)e0 * M + p0] = w0;
        ltok[(size_t)e1 * M + p1] = m; lw[(size_t)e1 * M + p1] = 1.f - w0;
        tpos[2 * m] = (e0 << 16) | (int)p0; tpos[2 * m + 1] = (e1 << 16) | (int)p1;
    }
    __syncthreads();
}
__device__ __forceinline__ void moe_plan(Frame& F) {
    LAS int* PLAN = (LAS int*)(F.lds + PLAN_OFF);
    __syncthreads();
    if (cur_tid() == 0) { int acc = 0;
        for (int e = 0; e < 8; ++e) { const int c = (int)__hip_atomic_load((unsigned*)(F.ctl + CW_CNT + 64 * e), RLX_AGENT); PLAN[e] = acc; PLAN[9 + e] = c; acc += (c + 255) >> 8; }
        PLAN[8] = acc; PLAN[17] = acc; }
    __syncthreads();
}
__device__ __forceinline__ void moe_gather(Frame& F, const bf16* H, bf16* XS, const int* ltok, const float* lw, float* sw) {
    const LAS int* PLAN = (const LAS int*)(F.lds + PLAN_OFF);
    const int gw = F.vcu * NWAVES + F.wave, NGW = F.G * NWAVES, nslot = PLAN[17] * 256;
    for (int sg = gw; sg < nslot; sg += NGW) {
        const int tile = sg >> 8; int e = 0;
#pragma unroll
        for (int j = 1; j < 8; ++j) e += (tile >= PLAN[j]) ? 1 : 0;
        const int idx = (tile - PLAN[e]) * 256 + (sg & 255); const bool valid = idx < PLAN[9 + e];
        int tok = 0; float w = 0.f;
        if (valid) { tok = ltok[(size_t)e * M + idx]; w = lw[(size_t)e * M + idx]; }
        const GAS v4u* src = (const GAS v4u*)((const unsigned char*)H + (size_t)tok * D) + F.lane; GAS v4u* dst = (GAS v4u*)((unsigned char*)XS + (size_t)sg * D) + F.lane;
        dst[0] = src[0];
        if (F.lane == 0) sw[sg] = w;
    }
}


__device__ __forceinline__ void moe_combine(Frame& F, float* out, const bf16* YS, const int* tpos) {
    const LAS int* PLAN = (const LAS int*)(F.lds + PLAN_OFF);
    const int gw = F.vcu * NWAVES + F.wave, NGW = F.G * NWAVES;
    for (int m = gw; m < M; m += NGW) {
        const int t0 = tpos[2 * m], t1 = tpos[2 * m + 1];
        const size_t s0 = (size_t)(PLAN[t0 >> 16] * 256 + (t0 & 0xffff)), s1 = (size_t)(PLAN[t1 >> 16] * 256 + (t1 & 0xffff));
        v4u xa[2], ya[2], yb[2];
#pragma unroll
        for (int j = 0; j < 2; ++j) { const int c = 512 * j + 8 * F.lane;
            xa[j] = *(const GAS v4u*)((const bf16*)out + (size_t)m * XLD + c); ya[j] = *(const GAS v4u*)(YS + s0 * D + c); yb[j] = *(const GAS v4u*)(YS + s1 * D + c); }
        asm volatile("s_waitcnt vmcnt(0)" ::: "memory");
#pragma unroll
        for (int j = 0; j < 2; ++j) { const int c = 512 * j + 8 * F.lane; const v4u x = xa[j], a = ya[j], b = yb[j];
            GAS f32x4* op = (GAS f32x4*)(out + (size_t)m * D + c); f32x4 o0, o1;
            o0.x = bflo(x.x) + (bflo(a.x) + bflo(b.x)); o0.y = bfhi(x.x) + (bfhi(a.x) + bfhi(b.x)); o0.z = bflo(x.y) + (bflo(a.y) + bflo(b.y)); o0.w = bfhi(x.y) + (bfhi(a.y) + bfhi(b.y));
            o1.x = bflo(x.z) + (bflo(a.z) + bflo(b.z)); o1.y = bfhi(x.z) + (bfhi(a.z) + bfhi(b.z)); o1.z = bflo(x.w) + (bflo(a.w) + bflo(b.w)); o1.w = bfhi(x.w) + (bfhi(a.w) + bfhi(b.w));
            op[0] = o0; op[1] = o1; }
    }
}

typedef short bf16x8 __attribute__((ext_vector_type(8)));
typedef float f32x16 __attribute__((ext_vector_type(16)));
constexpr size_t FR_SBK = 0, FR_SBV = 32 * MiB, FR_DFK = 64 * MiB, FR_DFV = 96 * MiB;
constexpr float LOG2E = 1.4426950408889634f;
constexpr int NKB = SEQ / 32;
#define MFMA32(a, b, c) __builtin_amdgcn_mfma_f32_32x32x16_bf16((a), (b), (c), 0, 0, 0)
__device__ __forceinline__ unsigned cvtpk(float lo, float hi) { return pg8::cvt_pk_bf16(lo, hi); }
__device__ __forceinline__ bf16x8 as_bf16x8(v4u v) { return __builtin_bit_cast(bf16x8, v); }

struct EpiQkStore {
    static constexpr bool STAGE = false; static constexpr bool PERM = true, PERMV = false, AFTER_DRAIN = false;
    bf16* O; int ldc; const float* sa; const float* swc; unsigned char* fragk; const float* gk; LAS float* xch; unsigned char* fragsk;
    __device__ __forceinline__ void operator()(const pg8::f32x4 (&acc)[2][2][4][2], const pg8::Unit& u, int wr, int wc, int fr, int fq) const {
        const int row0 = u.pm * 256 + wr * 64 + fr, col0 = u.pn * 256 + wc * 32 + 8 * fq;
        pg8::f32x4 cs[2][2]; float rsv[2][4];
#pragma unroll
        for (int bj = 0; bj < 2; ++bj)
#pragma unroll
            for (int n = 0; n < 2; ++n) cs[bj][n] = *(const pg8::f32x4*)(swc + col0 + bj * 128 + 4 * n);
#pragma unroll
        for (int ai = 0; ai < 2; ++ai)
#pragma unroll
            for (int m = 0; m < 4; ++m) rsv[ai][m] = sa[row0 + ai * 128 + m * 16];
        if (u.pn == 2 || u.pn == 3) {
#pragma unroll
            for (int ai = 0; ai < 2; ++ai)
#pragma unroll
                for (int m = 0; m < 4; ++m) { const int r = u.pm * 256 + ai * 128 + wr * 64 + m * 16 + fr; const float rs = rsv[ai][m];
                    const int b = r >> 13, kb = (r & (SEQ - 1)) >> 5, key = r & 31;
#pragma unroll
                    for (int bj = 0; bj < 2; ++bj) { const pg8::f32x4 v0 = pg8::acc_i2f(acc[ai][bj][m][0], rs) * cs[bj][0], v1 = pg8::acc_i2f(acc[ai][bj][m][1], rs) * cs[bj][1];
                        pg8::u32x4 w; w.x = pg8::cvt_pk_bf16(v0[0], v0[1]); w.y = pg8::cvt_pk_bf16(v0[2], v0[3]); w.z = pg8::cvt_pk_bf16(v1[0], v1[1]); w.w = pg8::cvt_pk_bf16(v1[2], v1[3]);
                        const int hm = 4 * (u.pn - 2) + 2 * bj + (wc >> 1), kk = 2 * (wc & 1) + (fq >> 1);
                        *(pg8::u32x4*)(fragsk + ((size_t)((b * 8 + hm) * NKB + kb) * 4 + kk) * 1024 + (size_t)(key + 32 * (fq & 1)) * 16) = w; } }
            return;
        }
        if (u.pn < 8) {
#pragma unroll
            for (int ai = 0; ai < 2; ++ai)
#pragma unroll
                for (int m = 0; m < 4; ++m) { const int row = row0 + ai * 128 + m * 16; bf16* rowp = O + (size_t)row * ldc + col0; const float rs = rsv[ai][m];
#pragma unroll
                    for (int bj = 0; bj < 2; ++bj) { const pg8::f32x4 v0 = pg8::acc_i2f(acc[ai][bj][m][0], rs) * cs[bj][0], v1 = pg8::acc_i2f(acc[ai][bj][m][1], rs) * cs[bj][1];
                        pg8::u32x4 w; w.x = pg8::cvt_pk_bf16(v0[0], v0[1]); w.y = pg8::cvt_pk_bf16(v0[2], v0[3]); w.z = pg8::cvt_pk_bf16(v1[0], v1[1]); w.w = pg8::cvt_pk_bf16(v1[2], v1[3]);
                        *(pg8::u32x4*)(rowp + bj * 128) = w; } }
            return;
        }
        asm volatile("" : "+v"(fr), "+v"(fq));
        int xb = (wr * 64 + fr) * 8 + wc; asm volatile("" : "+v"(xb));
        LAS float* const xw = xch + xb; LAS float* const xp = xch + (xb ^ 1);
        const int dim0 = 32 * (wc & 1) + 8 * fq;
#pragma unroll
        for (int ai = 0; ai < 2; ++ai)
#pragma unroll
            for (int m = 0; m < 4; ++m) { const int rl = ai * 128 + wr * 64 + m * 16 + fr; const float rs = rsv[ai][m]; (void)rl;
#pragma unroll
                for (int bj = 0; bj < 2; ++bj) { const pg8::f32x4 v0 = pg8::acc_i2f(acc[ai][bj][m][0], rs) * cs[bj][0], v1 = pg8::acc_i2f(acc[ai][bj][m][1], rs) * cs[bj][1];
                    float ss = ((v0[0] * v0[0] + v0[1] * v0[1]) + (v0[2] * v0[2] + v0[3] * v0[3])) + ((v1[0] * v1[0] + v1[1] * v1[1]) + (v1[2] * v1[2] + v1[3] * v1[3]));
                    ss += __shfl_xor(ss, 16); ss += __shfl_xor(ss, 32);
                    if (fq == 0) xw[(ai * 128 + m * 16) * 8 + bj * 4] = ss; } }
        asm volatile("s_waitcnt lgkmcnt(0)\n\ts_barrier" ::: "memory");
        const pg8::f32x4 g0 = *(const pg8::f32x4*)(gk + dim0), g1 = *(const pg8::f32x4*)(gk + dim0 + 4);
#pragma unroll
        for (int ai = 0; ai < 2; ++ai)
#pragma unroll
            for (int m = 0; m < 4; ++m) { const int rl = ai * 128 + wr * 64 + m * 16 + fr, r = u.pm * 256 + rl; const float rs = rsv[ai][m];
                const int b = r >> 13, kb = (r & (SEQ - 1)) >> 5, key = r & 31;
#pragma unroll
                for (int bj = 0; bj < 2; ++bj) { const float ss = xw[(ai * 128 + m * 16) * 8 + bj * 4] + xp[(ai * 128 + m * 16) * 8 + bj * 4];
                    const float rstd = rsqrtf(ss * (1.f / 64.f) + NORM_EPS);
                    const pg8::f32x4 v0 = pg8::acc_i2f_again(acc[ai][bj][m][0], rs) * cs[bj][0] * rstd * g0, v1 = pg8::acc_i2f_again(acc[ai][bj][m][1], rs) * cs[bj][1] * rstd * g1;
                    pg8::u32x4 w; w.x = pg8::cvt_pk_bf16(v0[0], v0[1]); w.y = pg8::cvt_pk_bf16(v0[2], v0[3]); w.z = pg8::cvt_pk_bf16(v1[0], v1[1]); w.w = pg8::cvt_pk_bf16(v1[2], v1[3]);
                    const int hm = 4 * (u.pn - 8) + 2 * bj + (wc >> 1), kk = 2 * (wc & 1) + (fq >> 1);
                    *(pg8::u32x4*)(fragk + ((size_t)((b * 8 + hm) * NKB + kb) * 4 + kk) * 1024 + (size_t)(key + 32 * (fq & 1)) * 16) = w; } }
    }
};
struct EpiVtFrag {
    static constexpr bool STAGE = false; static constexpr bool PERM = false, PERMV = true, AFTER_DRAIN = false;
    unsigned char* frag; const float* sa; const float* swc_sb; const float* swc_df;
    __device__ __forceinline__ void operator()(const pg8::f32x4 (&acc)[2][2][4][2], const pg8::Unit& u, int wr, int wc, int fr, int fq) const {
        const int hq = fq & 1, s = fq >> 1;
        pg8::f32x4 cs[2][2]; float rsv[2][4]; size_t goff[2];
#pragma unroll
        for (int bj = 0; bj < 2; ++bj) { const int T = u.pn * 256 + bj * 128 + wc * 32;
#pragma unroll
            for (int n = 0; n < 2; ++n) cs[bj][n] = *(const pg8::f32x4*)(sa + T + 16 * s + 8 * n + 4 * hq);
            goff[bj] = (size_t)((T >> 13) * NKB + ((T & (SEQ - 1)) >> 5)); }
#pragma unroll
        for (int ai = 0; ai < 2; ++ai)
#pragma unroll
            for (int m = 0; m < 4; ++m) { const int r = u.pm * 256 + ai * 128 + wr * 64 + m * 16 + fr; rsv[ai][m] = (r < 512) ? swc_sb[r] : swc_df[r - 512]; }
#pragma unroll
        for (int ai = 0; ai < 2; ++ai)
#pragma unroll
            for (int m = 0; m < 4; ++m) { const int r = u.pm * 256 + ai * 128 + wr * 64 + m * 16 + fr; const float rs = rsv[ai][m];
#pragma unroll
                for (int bj = 0; bj < 2; ++bj) { const int b = (int)(goff[bj] >> 8), kb = (int)(goff[bj] & (NKB - 1));
                    size_t fo;
                    if (r < 512) fo = FR_SBV / 1024 + ((size_t)((b * 8 + (r >> 6)) * NKB + kb) * 4 + ((r >> 5) & 1) * 2 + s);
                    else { const int r2 = r - 512; fo = FR_DFV / 1024 + ((size_t)((b * 4 + (r2 >> 7)) * NKB + kb) * 8 + ((r2 >> 5) & 3) * 2 + s); }
                    const pg8::f32x4 v0 = pg8::acc_i2f(acc[ai][bj][m][0], rs) * cs[bj][0], v1 = pg8::acc_i2f(acc[ai][bj][m][1], rs) * cs[bj][1];
                    pg8::u32x4 w; w.x = pg8::cvt_pk_bf16(v0[0], v0[1]); w.y = pg8::cvt_pk_bf16(v0[2], v0[3]); w.z = pg8::cvt_pk_bf16(v1[0], v1[1]); w.w = pg8::cvt_pk_bf16(v1[2], v1[3]);
                    *(pg8::u32x4*)(frag + fo * 1024 + (size_t)((r & 31) + 32 * hq) * 16) = w; } }
    }
};
__device__ __forceinline__ void repack_kv(Frame& F, const bf16* proj, unsigned char* frag, const float* gk) {
    const int gw = F.vcu * NWAVES + F.wave, NGW = F.G * NWAVES, lane = F.lane, m = lane & 31, h = lane >> 5;
    for (int it = gw; it < BATCH * NKB * 8; it += NGW) {
        const int bk = it >> 3, item = 8 + (it & 7), b = bk >> 8, kb = bk & (NKB - 1);
        if (item < 16) {
            const bool df = item >= 8; const int hh = item & 7;
            const bf16* src = proj + (size_t)(b * SEQ + 32 * kb + m) * INW + (df ? C_DFK : C_SBK) + 64 * hh + 8 * h;
            v4u v[4];
#pragma unroll
            for (int kk = 0; kk < 4; ++kk) v[kk] = *(const GAS v4u*)(src + 16 * kk);
            if (df) {
                float x[32]; float ss = 0.f;
#pragma unroll
                for (int kk = 0; kk < 4; ++kk) { x[8 * kk + 0] = bflo(v[kk].x); x[8 * kk + 1] = bfhi(v[kk].x); x[8 * kk + 2] = bflo(v[kk].y); x[8 * kk + 3] = bfhi(v[kk].y);
                    x[8 * kk + 4] = bflo(v[kk].z); x[8 * kk + 5] = bfhi(v[kk].z); x[8 * kk + 6] = bflo(v[kk].w); x[8 * kk + 7] = bfhi(v[kk].w); }
#pragma unroll
                for (int i = 0; i < 32; ++i) ss += x[i] * x[i];
                ss += __shfl_xor(ss, 32);
                const float rstd = rsqrtf(ss * (1.f / 64.f) + NORM_EPS);
#pragma unroll
                for (int kk = 0; kk < 4; ++kk) { const f32x4 g0 = *(const GAS f32x4*)(gk + 16 * kk + 8 * h), g1 = *(const GAS f32x4*)(gk + 16 * kk + 8 * h + 4);
                    v[kk].x = pk2(x[8 * kk + 0] * rstd * g0.x, x[8 * kk + 1] * rstd * g0.y); v[kk].y = pk2(x[8 * kk + 2] * rstd * g0.z, x[8 * kk + 3] * rstd * g0.w);
                    v[kk].z = pk2(x[8 * kk + 4] * rstd * g1.x, x[8 * kk + 5] * rstd * g1.y); v[kk].w = pk2(x[8 * kk + 6] * rstd * g1.z, x[8 * kk + 7] * rstd * g1.w); }
            }
            GAS v4u* dst = (GAS v4u*)(frag + (df ? FR_DFK : FR_SBK) + ((size_t)((b * 8 + hh) * NKB + kb) * 4) * 1024) + lane;
#pragma unroll
            for (int kk = 0; kk < 4; ++kk) dst[kk * 64] = v[kk];
        } else {
            const bool df = item >= 24; const int hh = item & 7;
            const int colbase = df ? (C_DFV + 128 * (hh >> 1) + 64 * (hh & 1)) : (C_SBV + 64 * hh);
            const bf16* src = proj + (size_t)(b * SEQ + 32 * kb) * INW + colbase + m;
            GAS v4u* dst = df ? (GAS v4u*)(frag + FR_DFV + ((size_t)((b * 4 + (hh >> 1)) * NKB + kb) * 8 + 4 * (hh & 1)) * 1024) + lane
                              : (GAS v4u*)(frag + FR_SBV + ((size_t)((b * 8 + hh) * NKB + kb) * 4) * 1024) + lane;
#pragma unroll
            for (int db = 0; db < 2; ++db)
#pragma unroll
                for (int s = 0; s < 2; ++s) { unsigned e[8];
#pragma unroll
                    for (int j = 0; j < 8; ++j) e[j] = src[(size_t)(16 * s + 8 * (j >> 2) + 4 * h + (j & 3)) * INW + 32 * db];
                    v4u o; o.x = e[0] | (e[1] << 16); o.y = e[2] | (e[3] << 16); o.z = e[4] | (e[5] << 16); o.w = e[6] | (e[7] << 16);
                    dst[(db * 2 + s) * 64] = o; }
        }
    }
}

__device__ __forceinline__ void q_tile_issue(const bf16* q0, int lane, v4u (&t)[4]) {
    const int r = lane >> 3, ch = lane & 7;
#pragma unroll
    for (int it = 0; it < 4; ++it) t[it] = *(const GAS v4u*)(q0 + (size_t)(r + 8 * it) * INW + ch * 8);
}
__device__ __forceinline__ void q_tile_finish(const v4u (&t)[4], LAS unsigned char* st, int lane, v4u (&w)[4]) {
    const int r = lane >> 3, ch = lane & 7;
#pragma unroll
    for (int it = 0; it < 4; ++it) *(LAS v4u*)(st + (r + 8 * it) * 144 + ch * 16) = t[it];
    const int n = lane & 31, h = lane >> 5;
#pragma unroll
    for (int kk = 0; kk < 4; ++kk) w[kk] = *(const LAS v4u*)(st + n * 144 + (16 * kk + 8 * h) * 2);
}
__device__ __forceinline__ void load_q_tile(const bf16* q0, LAS unsigned char* st, int lane, v4u (&w)[4]) {
    const int r = lane >> 3, ch = lane & 7; v4u t[4];
#pragma unroll
    for (int it = 0; it < 4; ++it) t[it] = *(const GAS v4u*)(q0 + (size_t)(r + 8 * it) * INW + ch * 8);
#pragma unroll
    for (int it = 0; it < 4; ++it) *(LAS v4u*)(st + (r + 8 * it) * 144 + ch * 16) = t[it];
    const int n = lane & 31, h = lane >> 5;
#pragma unroll
    for (int kk = 0; kk < 4; ++kk) w[kk] = *(const LAS v4u*)(st + n * 144 + (16 * kk + 8 * h) * 2);
}
constexpr int SB_CHUNK = 2 * NWAVES;
__device__ __forceinline__ void attn_sb(Frame& F, const bf16* proj, const unsigned char* frag, bf16* Y, int task0) {
    const int lane = F.lane, n = lane & 31, h = lane >> 5;
    for (int task = task0 + F.wave; task < task0 + SB_CHUNK && task < BATCH * 8 * NKB; task += NWAVES) {
        const int qb = (NKB - 1) - (task >> 5), bh = task & 31, b = bh >> 3, hh = bh & 7;
        bf16x8 qf[4];
        { v4u qw[4]; load_q_tile(proj + (size_t)(b * SEQ + 32 * qb) * INW + C_SBQ + 64 * hh, F.lds + RING_OFF + F.wave * 8192, lane, qw); const float sc = 0.125f * LOG2E;
#pragma unroll
          for (int kk = 0; kk < 4; ++kk) { const v4u w = qw[kk]; v4u o;
              o.x = cvtpk(bflo(w.x) * sc, bfhi(w.x) * sc); o.y = cvtpk(bflo(w.y) * sc, bfhi(w.y) * sc); o.z = cvtpk(bflo(w.z) * sc, bfhi(w.z) * sc); o.w = cvtpk(bflo(w.w) * sc, bfhi(w.w) * sc);
              qf[kk] = as_bf16x8(o); } }
        f32x16 O0, O1;
#pragma unroll
        for (int i = 0; i < 16; ++i) { O0[i] = 0.f; O1[i] = 0.f; }
        float carry = 0.f;
        const GAS v4u* kbase = (const GAS v4u*)(frag + FR_SBK + (size_t)(bh * NKB) * 4096) + lane;
        const GAS v4u* vbase = (const GAS v4u*)(frag + FR_SBV + (size_t)(bh * NKB) * 4096) + lane;
        v4u kf[4], vf[4];
#pragma unroll
        for (int j = 0; j < 4; ++j) { kf[j] = kbase[(size_t)qb * 256 + j * 64]; vf[j] = vbase[(size_t)qb * 256 + j * 64]; }
        for (int kb = qb; kb >= 0; --kb) {
            v4u kn[4], vn[4];
            const int kbn = kb > 0 ? kb - 1 : 0;
#pragma unroll
            for (int j = 0; j < 4; ++j) { kn[j] = kbase[(size_t)kbn * 256 + j * 64]; vn[j] = vbase[(size_t)kbn * 256 + j * 64]; }
            f32x16 S;
#pragma unroll
            for (int i = 0; i < 16; ++i) S[i] = 0.f;
#pragma unroll
            for (int kk = 0; kk < 4; ++kk) S = MFMA32(as_bf16x8(kf[kk]), qf[kk], S);
            float lk[16], lb[16];
            const bool diag = (kb == qb);
#pragma unroll
            for (int i = 0; i < 16; ++i) { const float z = S[i]; const float L = __builtin_amdgcn_logf(1.f + __builtin_amdgcn_exp2f(-fabsf(z)));
                lk[i] = -(fmaxf(z, 0.f) + L); lb[i] = fminf(z, 0.f) - L;
                if (diag && ((i & 3) + 8 * (i >> 2) + 4 * h) >= n) { lk[i] = 0.f; lb[i] = -INFINITY; } }
            float rs[4], prs[4], T[4];
#pragma unroll
            for (int g = 0; g < 4; ++g) { rs[g] = (lk[4 * g] + lk[4 * g + 1]) + (lk[4 * g + 2] + lk[4 * g + 3]); prs[g] = __shfl_xor(rs[g], 32); T[g] = rs[g] + prs[g]; }
            float ST[4]; ST[3] = 0.f; ST[2] = T[3]; ST[1] = ST[2] + T[2]; ST[0] = ST[1] + T[1];
            float p[16];
#pragma unroll
            for (int g = 0; g < 4; ++g) { float ls = carry + ST[g] + (h == 0 ? prs[g] : 0.f);
#pragma unroll
                for (int j = 3; j >= 0; --j) { p[4 * g + j] = __builtin_amdgcn_exp2f(lb[4 * g + j] + ls); ls += lk[4 * g + j]; } }
            carry += ST[0] + T[0];
            v4u pw0, pw1;
            pw0.x = cvtpk(p[0], p[1]); pw0.y = cvtpk(p[2], p[3]); pw0.z = cvtpk(p[4], p[5]); pw0.w = cvtpk(p[6], p[7]);
            pw1.x = cvtpk(p[8], p[9]); pw1.y = cvtpk(p[10], p[11]); pw1.z = cvtpk(p[12], p[13]); pw1.w = cvtpk(p[14], p[15]);
            O0 = MFMA32(as_bf16x8(vf[0]), as_bf16x8(pw0), O0); O0 = MFMA32(as_bf16x8(vf[1]), as_bf16x8(pw1), O0);
            O1 = MFMA32(as_bf16x8(vf[2]), as_bf16x8(pw0), O1); O1 = MFMA32(as_bf16x8(vf[3]), as_bf16x8(pw1), O1);
            if (__builtin_amdgcn_ballot_w64(carry >= -40.f) == 0ull) break;
#pragma unroll
            for (int j = 0; j < 4; ++j) { kf[j] = kn[j]; vf[j] = vn[j]; }
        }
        { LAS unsigned char* st = F.lds + RING_OFF + F.wave * 8192;
#pragma unroll
          for (int g = 0; g < 4; ++g) {
              *(LAS v2u*)(st + n * 136 + (8 * g + 4 * h) * 2) = (v2u){cvtpk(O0[4 * g], O0[4 * g + 1]), cvtpk(O0[4 * g + 2], O0[4 * g + 3])};
              *(LAS v2u*)(st + n * 136 + (32 + 8 * g + 4 * h) * 2) = (v2u){cvtpk(O1[4 * g], O1[4 * g + 1]), cvtpk(O1[4 * g + 2], O1[4 * g + 3])}; }
          const LAS unsigned char* rd = st + (lane >> 3) * 136 + (lane & 7) * 16;
          bf16* yrow = Y + (size_t)(b * SEQ + 32 * qb + (lane >> 3)) * 1024 + 64 * hh + (lane & 7) * 8;
          v4u ov[4];
#pragma unroll
          for (int it = 0; it < 4; ++it) { const v2u a = *(const LAS v2u*)(rd + it * 8 * 136), c2 = *(const LAS v2u*)(rd + it * 8 * 136 + 8); ov[it] = (v4u){a.x, a.y, c2.x, c2.y}; }
#pragma unroll
          for (int it = 0; it < 4; ++it) *(GAS v4u*)(yrow + (size_t)it * 8 * 1024) = ov[it]; }
    }
}

constexpr int ATT_DONE_OFF = LDSCTL_OFF + 2048, ATT_Q_OFF = ATT_DONE_OFF + 128;
constexpr int ATT_RING = RING_OFF, ATT_SLOT = 16384, ATT_XO = RING_OFF + 65536;
static_assert(MOE_MAX_CHUNKS == 1, "the row-tile counters are indexed by the chunk-relative tile");
constexpr int CW_PANEL = 32768;
constexpr int CW_QUEUE = 9216;
__device__ __forceinline__ void glds16(const void* gsrc, unsigned lds_dst) { unsigned keep;
    asm volatile("s_mov_b32 %0, m0\n\ts_mov_b32 m0, %2\n\ts_nop 0\n\tglobal_load_lds_dwordx4 %1, off\n\ts_mov_b32 m0, %0" : "=&s"(keep) : "v"(gsrc), "s"(lds_dst) : "memory"); }
#define ATT_WAIT_BAR(N) asm volatile("s_waitcnt vmcnt(" #N ") lgkmcnt(0)\n\ts_barrier" ::: "memory")
__device__ __forceinline__ void attn_df(Frame& F, const bf16* proj, const unsigned char* frag, bf16* Y, const float* gq, const float* gk, const float* dl, const float* subg, float linit, int L) {
    const int w = F.wave, c = w & 1, qs = w >> 1;
    const float kmax = 8.f * wave_max(fabsf(gk[F.lane])) * 1.01f;
    const float lam = __expf(wave_sum(dl[F.lane] * dl[64 + F.lane])) - __expf(wave_sum(dl[128 + F.lane] * dl[192 + F.lane])) + linit;
    volatile LAS int* DONE = (volatile LAS int*)(F.lds + ATT_DONE_OFF);
    volatile LAS int* QW = (volatile LAS int*)(F.lds + ATT_Q_OFF);
    const unsigned lds0 = (unsigned)(size_t)(F.lds + ATT_RING);
    const int ncv = (L == 0) ? CVQ_ALL : 0;
    for (;;) {
        F.tid = cur_tid(); F.lane = F.tid & 63;
        const int lane = F.lane, n = lane & 31, h = lane >> 5;
        __syncthreads();
        if (F.tid == 0) QW[0] = (int)__hip_atomic_fetch_add((unsigned*)(F.ctl + CW_QUEUE + 64 * L), 1u, RLX_AGENT);
        if (lane == 0) { DONE[w] = 0; DONE[8 + w] = 0; }
        __syncthreads();
        int u = QW[0];
        constexpr int NDF = BATCH * 4 * (NKB / 4), NSB = BATCH * 8 * NKB / SB_CHUNK;
        if (u >= 256 && u < 256 + (NDF - 256) + ncv) { const int v = u - 256, T = (NDF - 256) + ncv, d0 = v * (NDF - 256) / T, d1 = (v + 1) * (NDF - 256) / T;
            if (d1 == d0) { convert_queue_unit(F, v - d0); continue; } u = 256 + d0; }
        else if (u >= NDF + ncv) u -= ncv;
        if (u >= NDF + NSB) break;
        if (u >= NDF) { attn_sb(F, proj, frag, Y, (u - NDF) * SB_CHUNK); continue; }
        const int qb4 = (NKB / 4 - 1) - (u >> 4), head = 3 - ((u & 15) >> 2), b = u & 3;
        const int qblk = 4 * qb4 + qs, kb_top = 4 * qb4 + 3;
        const float slope2 = exp2f(-2.f * (float)(head + 1)) * LOG2E, far_thr = 27.f + 2.f * (float)(head + 1);
        const unsigned char* psrc[2]; size_t pstep[2]; unsigned pdst[2];
#pragma unroll
        for (int i = 0; i < 2; ++i) { const int p = 2 * w + i;
            if (p < 8) { psrc[i] = frag + FR_DFK + (size_t)((b * 8 + 2 * head + (p >> 2)) * NKB) * 4096 + (size_t)(p & 3) * 1024 + lane * 16; pstep[i] = 4096; }
            else { psrc[i] = frag + FR_DFV + (size_t)((b * 4 + head) * NKB) * 8192 + (size_t)(p - 8) * 1024 + lane * 16; pstep[i] = 8192; }
            pdst[i] = lds0 + p * 1024; }
#define ATT_DMA(step) do { const int kbd_ = kb_top - (step); const int kbc_ = kbd_ > 0 ? kbd_ : 0; const unsigned so_ = (unsigned)(((step) & 7) * ATT_SLOT); \
        glds16(psrc[0] + (size_t)kbc_ * pstep[0], (unsigned)__builtin_amdgcn_readfirstlane(pdst[0] + so_)); glds16(psrc[1] + (size_t)kbc_ * pstep[1], (unsigned)__builtin_amdgcn_readfirstlane(pdst[1] + so_)); } while (0)
        v4u qt[4]; q_tile_issue(proj + (size_t)(b * SEQ + 32 * qblk) * INW + C_DFQ + (2 * head + c) * 64, lane, qt);
        ATT_DMA(0); ATT_DMA(1); ATT_DMA(2); ATT_DMA(3); ATT_DMA(4);
        bf16x8 qf[4]; float Bt;
        { v4u qw[4]; q_tile_finish(qt, F.lds + ATT_RING + 5 * ATT_SLOT + w * 6144, lane, qw);
          float x[32]; float ss = 0.f;
#pragma unroll
          for (int kk = 0; kk < 4; ++kk) { const v4u v = qw[kk];
              x[8 * kk + 0] = bflo(v.x); x[8 * kk + 1] = bfhi(v.x); x[8 * kk + 2] = bflo(v.y); x[8 * kk + 3] = bfhi(v.y); x[8 * kk + 4] = bflo(v.z); x[8 * kk + 5] = bfhi(v.z); x[8 * kk + 6] = bflo(v.w); x[8 * kk + 7] = bfhi(v.w); }
#pragma unroll
          for (int i = 0; i < 32; ++i) ss += x[i] * x[i];
          ss += __shfl_xor(ss, 32);
          const float rstd = rsqrtf(ss * (1.f / 64.f) + NORM_EPS) * (0.125f * LOG2E); float qn = 0.f;
#pragma unroll
          for (int kk = 0; kk < 4; ++kk) { const f32x4 g0 = *(const GAS f32x4*)(gq + 16 * kk + 8 * h), g1 = *(const GAS f32x4*)(gq + 16 * kk + 8 * h + 4);
              x[8 * kk + 0] *= rstd * g0.x; x[8 * kk + 1] *= rstd * g0.y; x[8 * kk + 2] *= rstd * g0.z; x[8 * kk + 3] *= rstd * g0.w;
              x[8 * kk + 4] *= rstd * g1.x; x[8 * kk + 5] *= rstd * g1.y; x[8 * kk + 6] *= rstd * g1.z; x[8 * kk + 7] *= rstd * g1.w;
              v4u o; o.x = cvtpk(x[8 * kk + 0], x[8 * kk + 1]); o.y = cvtpk(x[8 * kk + 2], x[8 * kk + 3]); o.z = cvtpk(x[8 * kk + 4], x[8 * kk + 5]); o.w = cvtpk(x[8 * kk + 6], x[8 * kk + 7]);
              qf[kk] = as_bf16x8(o); }
#pragma unroll
          for (int i = 0; i < 32; ++i) qn += x[i] * x[i];
          qn += __shfl_xor(qn, 32);
          Bt = sqrtf(qn) * kmax * 1.01f; }
        f32x16 O[4];
#pragma unroll
        for (int d = 0; d < 4; ++d)
#pragma unroll
            for (int i = 0; i < 16; ++i) O[d][i] = 0.f;
        const float tq = (float)(32 * qblk + n);
        const float cb0 = slope2 * ((float)(4 * h) - tq) - Bt;
#define ATT_BIAS(S_, kb_) do { const float kt_ = cb0 + slope2 * (float)(32 * (kb_)); _Pragma("unroll") for (int i_ = 0; i_ < 16; ++i_) S_[i_] = __builtin_fmaf(slope2, (float)((i_ & 3) + 8 * (i_ >> 2)), kt_); } while (0)
#define ATT_QK(S_, slotidx_, kb_) do { const LAS v4u* sk_ = (const LAS v4u*)(F.lds + ATT_RING + (slotidx_) * ATT_SLOT) + lane; \
        const v4u k0_ = sk_[(4 * c + 0) * 64], k1_ = sk_[(4 * c + 1) * 64], k2_ = sk_[(4 * c + 2) * 64], k3_ = sk_[(4 * c + 3) * 64]; ATT_BIAS(S_, kb_); \
        S_ = MFMA32(as_bf16x8(k0_), qf[0], S_); S_ = MFMA32(as_bf16x8(k1_), qf[1], S_); S_ = MFMA32(as_bf16x8(k2_), qf[2], S_); S_ = MFMA32(as_bf16x8(k3_), qf[3], S_); } while (0)
        ATT_WAIT_BAR(8);
        f32x16 SA, SB, LA;
#pragma unroll
        for (int i = 0; i < 16; ++i) { SA[i] = 0.f; SB[i] = 0.f; LA[i] = 0.f; }
        if (kb_top <= qblk) ATT_QK(SA, 0, kb_top);
        v4u ones_ = (v4u){0x3f803f80u, 0x3f803f80u, 0x3f803f80u, 0x3f803f80u}; asm volatile("" : "+v"(ones_));
#define ATT_SOFTPV(SCUR, DIAG_, VF_) do { \
                const LAS v4u* sl = (const LAS v4u*)(F.lds + ATT_RING + (st & 7) * ATT_SLOT) + lane; (void)sl; \
                float p[16]; \
                _Pragma("unroll") for (int i = 0; i < 16; ++i) p[i] = __builtin_amdgcn_exp2f(SCUR[i]); \
                if (DIAG_) { int dn_ = n - 4 * h; asm volatile("" : "+v"(dn_)); _Pragma("unroll") for (int i = 0; i < 16; ++i) if (((i & 3) + 8 * (i >> 2)) > dn_) p[i] = 0.f; }     \
                v4u pw0, pw1; \
                pw0.x = cvtpk(p[0], p[1]); pw0.y = cvtpk(p[2], p[3]); pw0.z = cvtpk(p[4], p[5]); pw0.w = cvtpk(p[6], p[7]); \
                pw1.x = cvtpk(p[8], p[9]); pw1.y = cvtpk(p[10], p[11]); pw1.z = cvtpk(p[12], p[13]); pw1.w = cvtpk(p[14], p[15]); \
                _Pragma("unroll") for (int dd = 0; dd < 4; ++dd) { O[dd] = MFMA32(as_bf16x8(VF_(2 * dd)), as_bf16x8(pw0), O[dd]); O[dd] = MFMA32(as_bf16x8(VF_(2 * dd + 1)), as_bf16x8(pw1), O[dd]); } \
                LA = MFMA32(as_bf16x8(ones_), as_bf16x8(pw0), LA); LA = MFMA32(as_bf16x8(ones_), as_bf16x8(pw1), LA); } while (0)
#define ATT_VLDS(j_) sl[(8 + (j_)) * 64]
#define ATT_VREG(j_) vf_[j_]
#define ATT_STEP_G(st_, SCUR, SNEXT) do { const int st = (st_); const int kb = kb_top - st; \
            ATT_WAIT_BAR(6);                                              \
            ATT_DMA(st + 5); \
            const bool act = (kb <= qblk), actn = (kb >= 1) && (kb - 1 <= qblk); \
            if (actn) ATT_QK(SNEXT, (st + 1) & 7, kb - 1); \
            if (act) ATT_SOFTPV(SCUR, kb == qblk, ATT_VLDS); \
        } while (0)
#define ATT_SEG_BAR() do { __builtin_amdgcn_sched_barrier(0); ATT_WAIT_BAR(4); __builtin_amdgcn_sched_barrier(0); } while (0)
#define ATT_PIN4(a_) asm volatile("" : "+v"(a_[0]), "+v"(a_[1]), "+v"(a_[2]), "+v"(a_[3]))
#define ATT_STEP_M(st_, SCUR, SNEXT) do { const int st = (st_); const int kb = kb_top - st; \
            ATT_SEG_BAR(); \
              \
            v4u vf_[8]; { const LAS v4u* sv_ = (const LAS v4u*)(F.lds + ATT_RING + (st & 7) * ATT_SLOT) + lane; _Pragma("unroll") for (int j_ = 0; j_ < 8; ++j_) vf_[j_] = sv_[(8 + j_) * 64]; } \
            v4u kfm_[4]; { const LAS v4u* sk_ = (const LAS v4u*)(F.lds + ATT_RING + ((st + 1) & 7) * ATT_SLOT) + lane; _Pragma("unroll") for (int j_ = 0; j_ < 4; ++j_) kfm_[j_] = sk_[(4 * c + j_) * 64]; } \
            float p[16]; \
            _Pragma("unroll") for (int i = 0; i < 16; ++i) p[i] = __builtin_amdgcn_exp2f(SCUR[i]); \
            v4u pw_[2]; \
            pw_[0].x = cvtpk(p[0], p[1]); pw_[0].y = cvtpk(p[2], p[3]); pw_[0].z = cvtpk(p[4], p[5]); pw_[0].w = cvtpk(p[6], p[7]); \
            pw_[1].x = cvtpk(p[8], p[9]); pw_[1].y = cvtpk(p[10], p[11]); pw_[1].z = cvtpk(p[12], p[13]); pw_[1].w = cvtpk(p[14], p[15]); \
            ATT_SEG_BAR(); \
              \
              \
            asm volatile("" : "+v"(pw_[0]), "+v"(pw_[1])); ATT_PIN4(kfm_); \
            ATT_BIAS(SNEXT, kb - 1); \
              \
            SNEXT = MFMA32(as_bf16x8(kfm_[0]), qf[0], SNEXT); SNEXT = MFMA32(as_bf16x8(kfm_[1]), qf[1], SNEXT); SNEXT = MFMA32(as_bf16x8(kfm_[2]), qf[2], SNEXT); SNEXT = MFMA32(as_bf16x8(kfm_[3]), qf[3], SNEXT); \
            ATT_DMA(st + 5); \
            _Pragma("unroll") for (int dd = 0; dd < 4; ++dd) { O[dd] = MFMA32(as_bf16x8(vf_[2 * dd]), as_bf16x8(pw_[0]), O[dd]); O[dd] = MFMA32(as_bf16x8(vf_[2 * dd + 1]), as_bf16x8(pw_[1]), O[dd]); } \
            LA = MFMA32(as_bf16x8(ones_), as_bf16x8(pw_[0]), LA); LA = MFMA32(as_bf16x8(ones_), as_bf16x8(pw_[1]), LA); \
            asm volatile("" : "+v"(SNEXT), "+v"(LA)); ATT_PIN4(O); \
        } while (0)
        ATT_STEP_G(0, SA, SB); ATT_STEP_G(1, SB, SA); ATT_STEP_G(2, SA, SB); ATT_STEP_G(3, SB, SA);
        int st_end;
        { const float lmin = -wave_max(-LA[0]);
          const float need = (far_thr - __builtin_amdgcn_logf(lmin)) / slope2;
          const float nf = fminf(fmaxf(ceilf((need - 1.f) * (1.f / 32.f)), 0.f), 1048576.f);
          if (lane == 0) DONE[w] = (3 - qs) + (int)nf;
          asm volatile("s_waitcnt lgkmcnt(0)\n\ts_barrier" ::: "memory");
          const LAS v4u* dn_ = (const LAS v4u*)(F.lds + ATT_DONE_OFF); const v4u d0_ = dn_[0], d1_ = dn_[1];
          const unsigned mx_ = max(max(max(d0_.x, d0_.y), max(d0_.z, d0_.w)), max(max(d1_.x, d1_.y), max(d1_.z, d1_.w)));
          const int sl_ = (int)__builtin_amdgcn_readfirstlane(mx_); st_end = sl_ < kb_top ? sl_ : kb_top; }
        { const int m_end = st_end < kb_top - 2 ? st_end : kb_top - 2; int st2 = 4;
          if (w >= 4) ATT_SEG_BAR();
          for (; st2 + 1 <= m_end; st2 += 2) { ATT_STEP_M(st2, SA, SB); ATT_STEP_M(st2 + 1, SB, SA); }
          if (st2 <= m_end) ATT_STEP_M(st2, SA, SB);
          if (w < 4) ATT_SEG_BAR();
        }
        if (kb_top >= 7 && st_end >= kb_top - 1) { ATT_STEP_G(kb_top - 1, SA, SB); ATT_STEP_G(kb_top, SB, SA); }
#undef ATT_STEP_G
#undef ATT_STEP_M
#undef ATT_SEG_BAR
#undef ATT_PIN4
#undef ATT_SOFTPV
#undef ATT_VLDS
#undef ATT_VREG
#undef ATT_QK
#undef ATT_BIAS
        float l = LA[0];
        asm volatile("s_waitcnt vmcnt(0)" ::: "memory");
        __syncthreads();
        LAS v4u* XO = (LAS v4u*)(F.lds + ATT_XO) + (qs * 16) * 64 + lane;
        if (c == 1) { const float a1 = -lam / l;
#pragma unroll
            for (int d = 0; d < 4; ++d)
#pragma unroll
                for (int g = 0; g < 4; ++g) XO[(4 * d + g) * 64] = (v4u){__float_as_uint(O[d][4 * g] * a1), __float_as_uint(O[d][4 * g + 1] * a1), __float_as_uint(O[d][4 * g + 2] * a1), __float_as_uint(O[d][4 * g + 3] * a1)}; }
        __syncthreads();
        if (c == 0) { const float a0 = 1.f / l; float ssq = 0.f;
#pragma unroll
            for (int d = 0; d < 4; ++d)
#pragma unroll
                for (int g = 0; g < 4; ++g) { const v4u x1 = XO[(4 * d + g) * 64];
                    O[d][4 * g] = O[d][4 * g] * a0 + __uint_as_float(x1.x); O[d][4 * g + 1] = O[d][4 * g + 1] * a0 + __uint_as_float(x1.y);
                    O[d][4 * g + 2] = O[d][4 * g + 2] * a0 + __uint_as_float(x1.z); O[d][4 * g + 3] = O[d][4 * g + 3] * a0 + __uint_as_float(x1.w);
                    ssq += (O[d][4 * g] * O[d][4 * g] + O[d][4 * g + 1] * O[d][4 * g + 1]) + (O[d][4 * g + 2] * O[d][4 * g + 2] + O[d][4 * g + 3] * O[d][4 * g + 3]); }
            ssq += __shfl_xor(ssq, 32);
            const float rn = rsqrtf(ssq * (1.f / 128.f) + NORM_EPS) * (1.f - linit);
            f32x4 ggv[4][4];
#pragma unroll
            for (int d = 0; d < 4; ++d)
#pragma unroll
                for (int g = 0; g < 4; ++g) ggv[d][g] = *(const GAS f32x4*)(subg + 32 * d + 8 * g + 4 * h);
            LAS unsigned char* st = (LAS unsigned char*)(F.lds + ATT_XO) + qs * 16384;
#pragma unroll
            for (int d = 0; d < 4; ++d)
#pragma unroll
                for (int g = 0; g < 4; ++g) { const f32x4 gg = ggv[d][g];
                    *(LAS v2u*)(st + n * 264 + (32 * d + 8 * g + 4 * h) * 2) = (v2u){cvtpk(O[d][4 * g] * rn * gg.x, O[d][4 * g + 1] * rn * gg.y), cvtpk(O[d][4 * g + 2] * rn * gg.z, O[d][4 * g + 3] * rn * gg.w)}; }
            const LAS unsigned char* rd = st + (lane >> 4) * 264 + (lane & 15) * 16;
            bf16* yrow = Y + (size_t)(b * SEQ + 32 * qblk + (lane >> 4)) * 1024 + 512 + 128 * head + (lane & 15) * 8;
            v4u ov[8];
#pragma unroll
            for (int it = 0; it < 8; ++it) { const v2u a = *(const LAS v2u*)(rd + it * 4 * 264), c2 = *(const LAS v2u*)(rd + it * 4 * 264 + 8); ov[it] = (v4u){a.x, a.y, c2.x, c2.y}; }
#pragma unroll
            for (int it = 0; it < 8; ++it) *(GAS v4u*)(yrow + (size_t)it * 4 * 1024) = ov[it]; }
    }
#undef ATT_DMA
    __syncthreads();
}

#ifndef N_LAUNCH_MODE
#define N_LAUNCH_MODE 1
#endif
struct Args { const float* in[19]; float* out; unsigned char* ws; int ph_lo, ph_hi; };
constexpr int PH_L0 = 2, PH_L1 = 13, PH_MOE = PH_L1 + 9, PH_COMB = PH_MOE + 2 * MOE_MAX_CHUNKS, NPHASES = PH_COMB + 1;

__global__ void __launch_bounds__(NWAVES * 64, 2) fwd_kernel(Args args) {
    extern __shared__ __attribute__((aligned(16))) unsigned char lds[];
    Frame F;
    F.lds = (LAS unsigned char*)lds;
    F.MISC = (volatile LAS unsigned*)(F.lds + MISC_OFF);
    F.tid = threadIdx.x; F.lane = F.tid & 63; F.wave = __builtin_amdgcn_readfirstlane(F.tid >> 6);
    F.G = gridDim.x; { const int bx = blockIdx.x; F.vcu = (F.G % 8 == 0) ? (bx % 8) * (F.G / 8) + bx / 8 : bx; }
    F.ws = args.ws; F.ctl = (gu32*)(args.ws + WS_CTL); F.in = (const __attribute__((address_space(4))) Frame::cfptr_t*)(unsigned long long)__builtin_amdgcn_kernarg_segment_ptr(); F.out = args.out;
    unsigned char* ws = args.ws;
    for (int u = F.tid; u < (LDS_BYTES - LDSCTL_OFF) / 4; u += NWAVES * 64) ((LAS unsigned*)(F.lds + LDSCTL_OFF))[u] = 0u;
    __syncthreads();
    const int lo = args.ph_lo, hi = args.ph_hi;
    XcdBarrier bar; bar.bar = (unsigned*)(F.ctl + CW_BAR); bar.x = 0; bar.st = nullptr;
    if (hi - lo > 1) bar = xcd_barrier_post((unsigned*)(F.ctl + CW_BAR), F.MISC + 8);
#define IN(k) (lo <= (k) && (k) < hi)
#define SEAM(k) do { if (lo <= (k) && (k) + 1 < hi) xcd_barrier(bar); } while (0)
#define REFRESH() do { F.tid = cur_tid(); F.lane = F.tid & 63; { unsigned long long kp_ = (unsigned long long)__builtin_amdgcn_kernarg_segment_ptr(); asm volatile("" : "+s"(kp_)); F.in = (const __attribute__((address_space(4))) Frame::cfptr_t*)kp_; } } while (0)
    bf16* const Hb = (bf16*)(ws + WS_H); bf16* const Yb = (bf16*)(ws + WS_Y); bf16* const PROJ = (bf16*)(ws + WS_PROJ);
    bf16* const GATES = (bf16*)(ws + WS_GATES); bf16* const MERGED = (bf16*)(ws + WS_MERGED); bf16* const HID = (bf16*)(ws + WS_HID);
    const int bx = (int)blockIdx.x; __builtin_assume(bx >= 0 && bx < 256);

    unsigned char* const H8 = ws + WS_H; float* const SA = (float*)(ws + WS_SA); float* const PMAX = (float*)(ws + WS_PMAX); const float* const SWC = (const float*)(ws + WS_SWC);
    if (IN(0)) { REFRESH(); if (F.vcu < INW / 32) convert_i8_colblock(F, F.in[2], INW, ws + WS_WT + WT_WIN, 0, (float*)(ws + WS_SWC) + wq_coff(0), F.vcu); norm_rows_i8<false>(F, F.in[0], F.in[1], H8, SA); }
    SEAM(0);

    for (int L = 0; L < 2; ++L) {
        const int base = L ? PH_L1 : PH_L0;
        const unsigned char* wt = ws + WS_WT + (size_t)L * WT_LAYER;
        if (IN(base + 0)) { REFRESH();
            { pg8::Gemm g{Hb, (const bf16*)(wt + WT_WIN), D / 2, D / 2}; pg8::QkOrder S; S.init(M, 2048, F.G, bx);
              EpiQkStore E{PROJ, INW, SA, SWC + wq_coff(2 * L), ws + WS_FRAG + FR_DFK, F.in[4] + L * 64, (LAS float*)(F.lds + LDSCTL_OFF + 4096), ws + WS_FRAG + FR_SBK};
              pg8::gemm_phase<EpiQkStore, pg8::QkOrder, true, true, 2>(F.lds + RING_OFF, g, S, E); }
            asm volatile("s_waitcnt vmcnt(0)" ::: "memory"); __syncthreads();
            { pg8::Gemm g{(const bf16*)(wt + WT_WIN), Hb, D / 2, D / 2}; pg8::VtOrder S; S.init(1024, M, F.G, bx); S.rsb = C_SBV; S.rdf = C_DFV;
              EpiVtFrag E{ws + WS_FRAG, SA, SWC + wq_coff(2 * L) + C_SBV, SWC + wq_coff(2 * L) + C_DFV};
              pg8::gemm_phase<EpiVtFrag, pg8::VtOrder, true, true, 2>(F.lds + RING_OFF, g, S, E); }
        }
        SEAM(base + 0);
        if (IN(base + 2)) { REFRESH();
            attn_df(F, PROJ, ws + WS_FRAG, Yb, F.in[3] + L * 64, F.in[4] + L * 64, F.in[5] + L * 256, F.in[6] + L * 128, 0.8f - 0.6f * __expf(-0.3f * (float)L), L); }
        SEAM(base + 2);
        if (IN(base + 3)) { REFRESH();
            pg8::Gemm g{Hb, (const bf16*)(wt + WT_WG), D / 2, D / 2}; pg8::GatesOrder S; S.init(M, D, F.G, bx);
            pg8::EpiStoreBf16Q<2> E{GATES, GATEW, F.in[8] + L * GATEW, SA, SWC + wq_coff(2 * L + 1), (LAS float*)(F.lds + LDSCTL_OFF + 4096)};
            pg8::gemm_phase<pg8::EpiStoreBf16Q<2>, pg8::GatesOrder, true, true, 2>(F.lds + RING_OFF, g, S, E);
        }
        if (lo <= base + 3 && base + 4 < hi) { asm volatile("s_waitcnt vmcnt(0)" ::: "memory"); __syncthreads(); }
        if (IN(base + 4)) { REFRESH();
            pg8::Gemm g{Yb, (const bf16*)(wt + WT_WSB), 1024, 512}; pg8::StaticOrder S; S.init(M, D, F.G, bx);
            pg8::EpiGateMul<false> E{MERGED, D, GATES, GATEW};
            pg8::gemm_phase<pg8::EpiGateMul<false>, pg8::StaticOrder, true, true>(F.lds + RING_OFF, g, S, E);
        }
        if (lo <= base + 4 && base + 5 < hi) { asm volatile("s_waitcnt vmcnt(0)" ::: "memory"); __syncthreads(); }
        if (IN(base + 5)) { REFRESH();
            pg8::Gemm g{Yb + 512, (const bf16*)(wt + WT_WDF), 1024, 512}; pg8::StaticOrder S; S.init(M, D, F.G, bx);
            pg8::EpiGateMul<true> E{MERGED, D, GATES + 1024, GATEW};
            pg8::gemm_phase<pg8::EpiGateMul<true>, pg8::StaticOrder, true, true>(F.lds + RING_OFF, g, S, E);
        }
        SEAM(base + 5);
        if (IN(base + 6)) { REFRESH();
            pg8::Gemm g{MERGED, (const bf16*)(wt + WT_WOUT), D, D}; pg8::StaticOrder S; S.init(M, D, F.G, bx);
            pg8::EpiResBf E{L ? nullptr : F.in[0], D, (bf16*)F.out, XLD};
            pg8::gemm_phase<pg8::EpiResBf, pg8::StaticOrder, true, true>(F.lds + RING_OFF, g, S, E);
        }
        SEAM(base + 6);
        if (L == 0) {
            if (IN(base + 7)) { REFRESH(); norm_rows_i8<true>(F, F.out, F.in[12], H8, SA); }
            SEAM(base + 7);
            if (IN(base + 8)) { REFRESH();
                pg8::Gemm g{Hb, (const bf16*)(ws + WS_WGU), D / 2, D / 2}; pg8::StaticOrder S; S.init(M, 2 * DFF, F.G, bx);
                pg8::EpiSwigluQ8 E{HID, DFF, SA, SWC + wq_coff(4), SWC + wq_coff(4) + DFF, (LAS float*)(F.lds + LDSCTL_OFF + 12288)};
                pg8::gemm_phase<pg8::EpiSwigluQ8, pg8::StaticOrder, true, true, 2>(F.lds + RING_OFF, g, S, E);
            }
            SEAM(base + 8);
            if (IN(base + 9)) { REFRESH();
                pg8::Gemm g{HID, (const bf16*)(ws + WS_WDOWN), DFF / 2, DFF / 2}; pg8::StaticOrder S; S.init(M, D, F.G, bx);
                pg8::EpiResBf8 E{nullptr, D, (bf16*)F.out, XLD, 1.f / SC_W2};
                pg8::gemm_phase<pg8::EpiResBf8, pg8::StaticOrder, true, true, 1>(F.lds + RING_OFF, g, S, E);
            }
            SEAM(base + 9);
            if (IN(base + 10)) { REFRESH(); norm_rows_i8<true>(F, F.out, F.in[1] + D, H8, SA); }
            SEAM(base + 10);
        } else {
            int* const LTOK = (int*)(ws + WS_LTOK); float* const LW = (float*)(ws + WS_LW); int* const TPOS = (int*)(ws + WS_STOK); float* const SW = (float*)(ws + WS_SW);
            bf16* const XS = (bf16*)(ws + WS_XS); bf16* const HIDC = (bf16*)(ws + WS_HIDC); bf16* const YS = (bf16*)(ws + WS_YS);
            if (IN(base + 7)) { REFRESH(); norm_route_rows(F, (const bf16*)F.out, F.in[12] + D, Hb, F.in[15], LTOK, LW, TPOS); }
            SEAM(base + 7);
            if (hi > base + 8) moe_plan(F);
            const LAS int* PLAN = (const LAS int*)(F.lds + PLAN_OFF);
            if (IN(base + 8)) { REFRESH(); moe_gather(F, Hb, XS, LTOK, LW, SW); }
            SEAM(base + 8);
            const int ntile = PLAN[17];
            for (int c = 0; c < MOE_MAX_CHUNKS; ++c) {
                const int tile0 = c * MOE_CHUNK_TILES, nt = (ntile - tile0) < MOE_CHUNK_TILES ? (ntile - tile0) : MOE_CHUNK_TILES;
                if (nt <= 0) break;
                int Gl = F.G; asm volatile("" : "+s"(Gl));
                const int n1 = nt * (2 * DFE / 256), n2 = nt * (D / 256), q2 = n2 / Gl, nH = n2 - q2 * Gl;
                int h1 = 0;
                if (nH > 0) { h1 = ((4 * n1 + 15 * nH) / Gl - 13) >> 2; h1 = h1 < 0 ? 0 : h1; if (h1 * nH > n1) h1 = n1 / nH; }
                unsigned* const PANEL = (unsigned*)(F.ctl + CW_PANEL);
                if (IN(PH_MOE + 2 * c)) { REFRESH();
                    pg8::MoeDeal<false, true> S1; S1.G = F.G; S1.c = bx; S1.tile0 = tile0; S1.nM = nt; S1.nN = 2 * DFE / 256; S1.nwg = n1; S1.a_tile_off = tile0; S1.b_exp_bytes = MOE13_EXP;
                    S1.nH = nH; S1.hk = h1; S1.pub = PANEL; S1.prev_pm = -1;
#pragma unroll
                    for (int j = 0; j < 9; ++j) S1.ts[j] = PLAN[j];
                    pg8::Gemm g{XS, (const bf16*)(ws + WS_MOE13), D / 2, D / 2};
                    pg8::EpiSwiglu8 E{(unsigned char*)HIDC, DFE, 1.f / SC_W13};
                    pg8::gemm_phase<pg8::EpiSwiglu8, pg8::MoeDeal<false, true>, true, true, true>(F.lds + RING_OFF, g, S1, E);
                    S1.publish_last();
                }
                if (IN(PH_MOE + 2 * c + 1)) { REFRESH();
                    pg8::MoeDeal<true, false> S2; S2.G = F.G; S2.c = bx; S2.tile0 = tile0; S2.nM = nt; S2.nN = D / 256; S2.nwg = n2; S2.a_tile_off = 0; S2.b_exp_bytes = MOE2_EXP;
                    S2.nH = nH; S2.hk = q2 + 1; S2.pub = nullptr; S2.prev_pm = -1;
#pragma unroll
                    for (int j = 0; j < 9; ++j) S2.ts[j] = PLAN[j];
                    if (F.wave == 0) {
                        int spins = 0;
                        for (int i = 0; spins < 400000; ++i) { pg8::Unit u; if (!S2.next(i, u)) break;
                            while (spins < 400000 && (unsigned)__builtin_amdgcn_readfirstlane(__hip_atomic_load(PANEL + 64 * u.pm, __ATOMIC_RELAXED, __HIP_MEMORY_SCOPE_AGENT)) < (unsigned)((2 * DFE / 256) * NWAVES)) {
                                ++spins; __builtin_amdgcn_s_sleep(2); } }
                        __builtin_amdgcn_fence(__ATOMIC_ACQUIRE, "agent");
                        asm volatile("s_waitcnt vmcnt(0)" ::: "memory"); }
                    __syncthreads();
                    pg8::Gemm g{HIDC, (const bf16*)(ws + WS_MOE2), DFE / 2, DFE / 2};
                    pg8::EpiMoeStore E{YS, D, SW, tile0 * 256, 1.f / SC_W2};
                    pg8::gemm_phase<pg8::EpiMoeStore, pg8::MoeDeal<true, false>, true, true, true>(F.lds + RING_OFF, g, S2, E);
                }
                SEAM(PH_MOE + 2 * c + 1);
            }
            if (IN(PH_COMB)) { REFRESH(); moe_combine(F, F.out, YS, TPOS); }
        }
    }
#undef IN
#undef SEAM
#undef REFRESH
}

extern "C" void kernel_launch(void* const* d_in, const int* in_sizes, int n_in, void* d_out, int out_size, void* d_ws, size_t ws_size, hipStream_t stream) {
    static int grid = 0;
    if (grid == 0) {
        if (n_in != 19 || in_sizes[0] != M * D || out_size != M * D || ws_size < WS_END) { fprintf(stderr, "kernel_launch: unexpected shapes (n_in %d, in0 %d, out %d, ws %zu < %zu); nothing launched\n", n_in, n_in > 0 ? in_sizes[0] : -1, out_size, ws_size, (size_t)WS_END); grid = -1; return; }
        int dev = 0, cus = 0, per_cu = 0;
        if (hipGetDevice(&dev) != hipSuccess || hipDeviceGetAttribute(&cus, hipDeviceAttributeMultiprocessorCount, dev) != hipSuccess) { grid = -1; return; }
        if (hipFuncSetAttribute((const void*)fwd_kernel, hipFuncAttributeMaxDynamicSharedMemorySize, LDS_BYTES) != hipSuccess) { fprintf(stderr, "kernel_launch: hipFuncSetAttribute failed\n"); grid = -1; return; }
        if (hipOccupancyMaxActiveBlocksPerMultiprocessor(&per_cu, (const void*)fwd_kernel, NWAVES * 64, LDS_BYTES) != hipSuccess || per_cu < 1)
            fprintf(stderr, "kernel_launch: note: occupancy query reports %d workgroups per CU\n", per_cu);
        (void)hipGetLastError();
        grid = cus < 256 ? (cus / 8) * 8 : 256;
        if (grid < 32) { grid = -1; return; }
    }
    if (grid < 0) return;
    if (hipMemsetAsync((char*)d_ws + WS_CTL, 0, CTL_ZERO_BYTES, stream) != hipSuccess) return;
    Args a{};
    for (int i = 0; i < 19; ++i) a.in[i] = (const float*)d_in[i];
    a.out = (float*)d_out; a.ws = (unsigned char*)d_ws;
#if N_LAUNCH_MODE == 1
    a.ph_lo = 0; a.ph_hi = NPHASES;
    hipLaunchKernelGGL(fwd_kernel, dim3(grid), dim3(NWAVES * 64), LDS_BYTES, stream, a);
#else
    for (int p = 0; p < NPHASES; ++p) { a.ph_lo = p; a.ph_hi = p + 1; hipLaunchKernelGGL(fwd_kernel, dim3(grid), dim3(NWAVES * 64), LDS_BYTES, stream, a); }
#endif
}
```

```cpp
#include <hip/hip_runtime.h>
__device__ __forceinline__ int cur_tid() { int l; asm volatile("v_mbcnt_lo_u32_b32 %0, -1, 0\n\tv_mbcnt_hi_u32_b32 %0, -1, %0" : "=v"(l)); return (__builtin_amdgcn_readfirstlane((int)threadIdx.x >> 6) << 6) | l; }
#include <cstdio>
#include <cstdint>

namespace pg8 {
#define PG8_LAS __attribute__((address_space(3)))
typedef unsigned short bf16_t;
typedef short bf16x8 __attribute__((ext_vector_type(8)));
typedef float f32x4 __attribute__((ext_vector_type(4)));
typedef unsigned u32x4 __attribute__((ext_vector_type(4)));
constexpr int BM = 256, BK = 64, HALF = 128, HTB = HALF * BK * 2  , STAGE_BYTES = 8 * HTB, NXCD = 8, WGM = 8;

__host__ __device__ __forceinline__ int lds_byte(int r, int c) { const int st = (r >> 4) * 2 + (c >> 5), rr = r & 15, cc = c & 31, ob = rr * 64 + cc * 2; return st * 1024 + (ob ^ (((ob >> 9) & 1) << 5)); }
__host__ __device__ __forceinline__ void stage_rc(int b, int& R, int& C) { const int st = b / 1024, sb = b % 1024, swz = sb ^ (((sb >> 9) & 1) << 5); R = (st >> 1) * 16 + swz / 64; C = (st & 1) * 32 + (swz % 64) / 2; }
__host__ __device__ __forceinline__ int permv32(int rho) { const int n = rho >> 4, i = rho & 15, fq = i >> 2, e = i & 3; return 16 * (fq >> 1) + 8 * n + 4 * (fq & 1) + e; }
__host__ __device__ __forceinline__ int perm32(int rho) { const int n = rho >> 4, i = rho & 15; return 8 * (i >> 2) + 4 * n + (i & 3); }

struct Unit { int pm, pn, e, par; };
struct Gemm { const bf16_t* A; const bf16_t* Bt; int lda, K; };

struct StaticOrder {
    int nM, nN, nwg, G, c;
    __host__ __device__ void init(int M, int N, int G_, int c_) { nM = M / BM; nN = N / BM; nwg = nM * nN; G = G_; c = c_; }
    __host__ __device__ bool next(int i, Unit& u) const {
        const long L = (long)i * G + c; if (L >= nwg) return false;
        int wgid = (int)L; { const int q = nwg / NXCD, r = nwg % NXCD, xcd = wgid % NXCD, off = wgid / NXCD; wgid = (xcd < r ? xcd * (q + 1) : r * (q + 1) + (xcd - r) * q) + off; }
        const int nig = WGM * nN, gid = wgid / nig, fm = gid * WGM, gsz = (nM - fm) < WGM ? (nM - fm) : WGM;
        u.pm = fm + ((wgid % nig) % gsz); u.pn = (wgid % nig) / gsz; u.e = 0; return true;
    }
    __device__ __forceinline__ const char* a_ptr(const Gemm& g, const Unit& u) const { return (const char*)g.A + (size_t)u.pm * ((size_t)BM * g.lda * 2); }
    __device__ __forceinline__ const char* b_ptr(const Gemm& g, const Unit& u) const { return (const char*)g.Bt + (size_t)u.pn * ((size_t)BM * g.K * 2); }
    __device__ __forceinline__ void a_ready(const Unit&) const {}
    __device__ __forceinline__ void done(const Unit&) const {}
};
struct MoeOrder {
    int nM, nN, nwg, G, c, tile0, a_tile_off; int ts[9]; size_t b_exp_bytes;
    __device__ __forceinline__ void unit_at(long L, Unit& u) const {
        int wgid = (int)L; { const int q = nwg / NXCD, r = nwg % NXCD, xcd = wgid % NXCD, off = wgid / NXCD; wgid = (xcd < r ? xcd * (q + 1) : r * (q + 1) + (xcd - r) * q) + off; }
        const int nig = WGM * nN, gid = wgid / nig, fm = gid * WGM, gsz = (nM - fm) < WGM ? (nM - fm) : WGM;
        u.pm = fm + ((wgid % nig) % gsz); u.pn = (wgid % nig) / gsz;
        const int t = tile0 + u.pm; int e = 0;
#pragma unroll
        for (int j = 1; j < 8; ++j) e += (t >= ts[j]) ? 1 : 0;
        u.e = e;
    }
    __device__ __forceinline__ bool next(int i, Unit& u) const {
        const long L = (long)i * G + c; if (L >= nwg) return false;
        unit_at(L, u); return true;
    }
    __device__ __forceinline__ const char* a_ptr(const Gemm& g, const Unit& u) const { return (const char*)g.A + (size_t)(u.pm + a_tile_off) * ((size_t)BM * g.lda * 2); }
    __device__ __forceinline__ const char* b_ptr(const Gemm& g, const Unit& u) const { return (const char*)g.Bt + (size_t)u.e * b_exp_bytes + (size_t)u.pn * ((size_t)BM * g.K * 2); }
    __device__ __forceinline__ void a_ready(const Unit&) const {}
    __device__ __forceinline__ void done(const Unit&) const {}
};

struct QkOrder : StaticOrder {
    __device__ __forceinline__ bool next(int i, Unit& u) const { if (!StaticOrder::next(i, u)) return false; u.pn = u.pn < 4 ? u.pn : u.pn + 2; return true; }
};
struct GatesOrder : StaticOrder {
    __device__ __forceinline__ bool next(int i, Unit& u) const { if (!StaticOrder::next(i >> 1, u)) return false; u.pn += 4 * (i & 1); return true; }
};
struct VtOrder : StaticOrder {
    int rsb, rdf;
    __device__ __forceinline__ const char* a_ptr(const Gemm& g, const Unit& u) const { return (const char*)g.A + (size_t)(u.pm < 2 ? rsb + BM * u.pm : rdf + BM * (u.pm - 2)) * ((size_t)g.lda * 2); }
};

template <bool HFIRST, bool PUB> struct MoeDeal : MoeOrder {
    static constexpr bool h_first = HFIRST;
    int nH, hk; unsigned* pub; mutable int prev_pm;
    __device__ __forceinline__ bool next(int i, Unit& u) const {
        const int nheavy = nH * hk, jh = c - (G - nH); long L;
        if (jh >= 0) { if (i >= hk) return false; L = (h_first ? 0 : nwg - nheavy) + (long)i * nH + jh; }
        else { L = (h_first ? nheavy : 0) + (long)i * (G - nH) + c; if (L >= (h_first ? nwg : nwg - nheavy)) return false; }
        unit_at(L, u); return true;
    }
    __device__ __forceinline__ void done(const Unit& u) const {
        if constexpr (PUB) { asm volatile("s_waitcnt vmcnt(16)" ::: "memory");
            if (prev_pm >= 0 && ((cur_tid() & 63) == 0)) __hip_atomic_fetch_add(pub + 64 * prev_pm, 1u, __ATOMIC_RELAXED, __HIP_MEMORY_SCOPE_AGENT);
            prev_pm = u.pm; }
    }
    __device__ __forceinline__ void publish_last() const {
        if constexpr (PUB) { asm volatile("s_waitcnt vmcnt(0)" ::: "memory");
            if (prev_pm >= 0 && ((cur_tid() & 63) == 0)) __hip_atomic_fetch_add(pub + 64 * prev_pm, 1u, __ATOMIC_RELAXED, __HIP_MEMORY_SCOPE_AGENT);
            prev_pm = -1; }
    }
};

typedef float f32x2_t __attribute__((ext_vector_type(2))); typedef __bf16 bf16x2_t __attribute__((ext_vector_type(2)));
__device__ __forceinline__ unsigned cvt_pk_bf16(float lo, float hi) { f32x2_t v = {lo, hi}; bf16x2_t b = __builtin_convertvector(v, bf16x2_t); return __builtin_bit_cast(unsigned, b); }
typedef int v8i_t __attribute__((ext_vector_type(8)));
typedef int v4i_t __attribute__((ext_vector_type(4)));
__device__ __forceinline__ unsigned pack4_i8(float a, float b, float c, float d) {
    const int q0 = (int)__builtin_fminf(__builtin_fmaxf(__builtin_rintf(a), -127.f), 127.f), q1 = (int)__builtin_fminf(__builtin_fmaxf(__builtin_rintf(b), -127.f), 127.f);
    const int q2 = (int)__builtin_fminf(__builtin_fmaxf(__builtin_rintf(c), -127.f), 127.f), q3 = (int)__builtin_fminf(__builtin_fmaxf(__builtin_rintf(d), -127.f), 127.f);
    return (unsigned)(q0 & 255) | ((unsigned)(q1 & 255) << 8) | ((unsigned)(q2 & 255) << 16) | ((unsigned)(q3 & 255) << 24); }
__device__ __forceinline__ v8i_t cat8(bf16x8 lo, bf16x8 hi) { const u32x4 a = __builtin_bit_cast(u32x4, lo), b = __builtin_bit_cast(u32x4, hi); return (v8i_t){(int)a.x, (int)a.y, (int)a.z, (int)a.w, (int)b.x, (int)b.y, (int)b.z, (int)b.w}; }
__device__ __forceinline__ void mfma_f8_acc(f32x4& acc, const v8i_t& b, const v8i_t& a, int sc) { asm volatile("v_mfma_scale_f32_16x16x128_f8f6f4 %0, %1, %2, %0, %3, %3 op_sel_hi:[0,0,0]" : "+v"(acc) : "v"(b), "v"(a), "v"(sc)); }
__device__ __forceinline__ float clamp_f8(float v) { return __builtin_fminf(__builtin_fmaxf(v, -448.f), 448.f); }
__device__ __forceinline__ unsigned pack4_f8(float a, float b, float c, float d) { unsigned w = 0u; w = __builtin_amdgcn_cvt_pk_fp8_f32(clamp_f8(a), clamp_f8(b), w, false); w = __builtin_amdgcn_cvt_pk_fp8_f32(clamp_f8(c), clamp_f8(d), w, true); return w; }
__device__ __forceinline__ float bf_lo(unsigned w) { return __uint_as_float(w << 16); }
__device__ __forceinline__ float bf_hi(unsigned w) { return __uint_as_float(w & 0xffff0000u); }
__device__ __forceinline__ float sigmoid_f(float v) { return __builtin_amdgcn_rcpf(1.0f + __expf(-v)); }

template <int ACT> struct EpiStoreBf16 {
    static constexpr bool STAGE = false; static constexpr bool PERM = true, PERMV = false, AFTER_DRAIN = false;
    bf16_t* O; int ldc; const float* bias;
    __device__ __forceinline__ void operator()(const f32x4 (&acc)[2][2][4][2], const Unit& u, int wr, int wc, int fr, int fq) const {
        const int row0 = u.pm * BM + wr * 64 + fr, col0 = u.pn * BM + wc * 32 + 8 * fq;
        f32x4 bv[2][2];
#pragma unroll
        for (int bj = 0; bj < 2; ++bj)
#pragma unroll
            for (int n = 0; n < 2; ++n) bv[bj][n] = bias ? *(const f32x4*)(bias + col0 + bj * HALF + 4 * n) : (f32x4){0.f, 0.f, 0.f, 0.f};
#pragma unroll
        for (int ai = 0; ai < 2; ++ai)
#pragma unroll
            for (int m = 0; m < 4; ++m) { bf16_t* rowp = O + (size_t)(row0 + ai * HALF + m * 16) * ldc + col0;
#pragma unroll
                for (int bj = 0; bj < 2; ++bj) { f32x4 v0 = acc[ai][bj][m][0] + bv[bj][0], v1 = acc[ai][bj][m][1] + bv[bj][1];
                    if (ACT == 2) {
#pragma unroll
                        for (int j = 0; j < 4; ++j) { v0[j] = sigmoid_f(v0[j]); v1[j] = sigmoid_f(v1[j]); } }
                    u32x4 w; w.x = cvt_pk_bf16(v0[0], v0[1]); w.y = cvt_pk_bf16(v0[2], v0[3]); w.z = cvt_pk_bf16(v1[0], v1[1]); w.w = cvt_pk_bf16(v1[2], v1[3]);
                    *(u32x4*)(rowp + bj * HALF) = w; } }
    }
};
template <bool ACCUM> struct EpiGateMul {
    static constexpr bool STAGE = false; static constexpr bool PERM = true, PERMV = false, AFTER_DRAIN = false;
    bf16_t* O; int ldo; const bf16_t* Gt; int ldg;
    __device__ __forceinline__ void operator()(const f32x4 (&acc)[2][2][4][2], const Unit& u, int wr, int wc, int fr, int fq) const {
        const int row0 = u.pm * BM + wr * 64 + fr, col0 = u.pn * BM + wc * 32 + 8 * fq;
#pragma unroll
        for (int ai = 0; ai < 2; ++ai) {
            u32x4 gv[4][2], pv[4][2];
#pragma unroll
            for (int m = 0; m < 4; ++m)
#pragma unroll
                for (int bj = 0; bj < 2; ++bj) { const size_t row = (size_t)(row0 + ai * HALF + m * 16); const int col = col0 + bj * HALF;
                    gv[m][bj] = *(const u32x4*)(Gt + row * ldg + col); if (ACCUM) pv[m][bj] = *(const u32x4*)(O + row * ldo + col); }
#pragma unroll
            for (int m = 0; m < 4; ++m)
#pragma unroll
                for (int bj = 0; bj < 2; ++bj) { const size_t row = (size_t)(row0 + ai * HALF + m * 16); const int col = col0 + bj * HALF;
                    const u32x4 gw = gv[m][bj]; f32x4 v0 = acc[ai][bj][m][0], v1 = acc[ai][bj][m][1];
                    v0[0] *= bf_lo(gw.x); v0[1] *= bf_hi(gw.x); v0[2] *= bf_lo(gw.y); v0[3] *= bf_hi(gw.y);
                    v1[0] *= bf_lo(gw.z); v1[1] *= bf_hi(gw.z); v1[2] *= bf_lo(gw.w); v1[3] *= bf_hi(gw.w);
                    if (ACCUM) { const u32x4 pw = pv[m][bj];
                        v0[0] += bf_lo(pw.x); v0[1] += bf_hi(pw.x); v0[2] += bf_lo(pw.y); v0[3] += bf_hi(pw.y);
                        v1[0] += bf_lo(pw.z); v1[1] += bf_hi(pw.z); v1[2] += bf_lo(pw.w); v1[3] += bf_hi(pw.w); }
                    u32x4 w; w.x = cvt_pk_bf16(v0[0], v0[1]); w.y = cvt_pk_bf16(v0[2], v0[3]); w.z = cvt_pk_bf16(v1[0], v1[1]); w.w = cvt_pk_bf16(v1[2], v1[3]);
                    *(u32x4*)(O + row * ldo + col) = w; }
        }
    }
};
struct EpiResF32 {
    static constexpr bool STAGE = false; static constexpr bool PERM = false, PERMV = false, AFTER_DRAIN = false;
    const float* base; float* out; int ldc;
    __device__ __forceinline__ void operator()(const f32x4 (&acc)[2][2][4][2], const Unit& u, int wr, int wc, int fr, int fq) const {
        const int col0 = u.pn * BM + wc * 32 + 4 * fq;
#pragma unroll
        for (int ai = 0; ai < 2; ++ai) {
            f32x4 bs[4][2][2];
#pragma unroll
            for (int m = 0; m < 4; ++m) { const size_t off = (size_t)(u.pm * BM + ai * HALF + wr * 64 + m * 16 + fr) * ldc + col0;
#pragma unroll
                for (int bj = 0; bj < 2; ++bj)
#pragma unroll
                    for (int n = 0; n < 2; ++n) bs[m][bj][n] = *(const f32x4*)(base + off + bj * HALF + n * 16); }
#pragma unroll
            for (int m = 0; m < 4; ++m) { const size_t off = (size_t)(u.pm * BM + ai * HALF + wr * 64 + m * 16 + fr) * ldc + col0;
#pragma unroll
                for (int bj = 0; bj < 2; ++bj)
#pragma unroll
                    for (int n = 0; n < 2; ++n) *(f32x4*)(out + off + bj * HALF + n * 16) = bs[m][bj][n] + acc[ai][bj][m][n]; }
        }
    }
};
template <bool SC> struct EpiResBfT {
    static constexpr bool STAGE = false; static constexpr bool PERM = true, PERMV = false, AFTER_DRAIN = false; static constexpr int NST = 0;
    const float* basef; int ldf; bf16_t* xb; int ldb; float ascale;
    __device__ __forceinline__ void operator()(const f32x4 (&acc)[2][2][4][2], const Unit& u, int wr, int wc, int fr, int fq) const {
        const int col0 = u.pn * BM + wc * 32 + 8 * fq;
#pragma unroll
        for (int ai = 0; ai < 2; ++ai) {
            if constexpr (SC) {
                u32x4 wv[4][2];
#pragma unroll
                for (int m = 0; m < 4; ++m) { const size_t row = (size_t)(u.pm * BM + ai * HALF + wr * 64 + m * 16 + fr);
#pragma unroll
                    for (int bj = 0; bj < 2; ++bj) wv[m][bj] = *(const u32x4*)(xb + row * ldb + col0 + bj * HALF); }
#pragma unroll
                for (int m = 0; m < 4; ++m) { const size_t row = (size_t)(u.pm * BM + ai * HALF + wr * 64 + m * 16 + fr);
#pragma unroll
                    for (int bj = 0; bj < 2; ++bj) { const u32x4 w0 = wv[m][bj];
                        const f32x4 v0 = (f32x4){bf_lo(w0.x), bf_hi(w0.x), bf_lo(w0.y), bf_hi(w0.y)} + acc[ai][bj][m][0] * ascale, v1 = (f32x4){bf_lo(w0.z), bf_hi(w0.z), bf_lo(w0.w), bf_hi(w0.w)} + acc[ai][bj][m][1] * ascale;
                        u32x4 w; w.x = cvt_pk_bf16(v0[0], v0[1]); w.y = cvt_pk_bf16(v0[2], v0[3]); w.z = cvt_pk_bf16(v1[0], v1[1]); w.w = cvt_pk_bf16(v1[2], v1[3]);
                        *(u32x4*)(xb + row * ldb + col0 + bj * HALF) = w; } }
                continue; }
            f32x4 b0[4][2], b1[4][2];
#pragma unroll
            for (int m = 0; m < 4; ++m) { const size_t row = (size_t)(u.pm * BM + ai * HALF + wr * 64 + m * 16 + fr);
#pragma unroll
                for (int bj = 0; bj < 2; ++bj) { const int col = col0 + bj * HALF;
                    if (basef) { b0[m][bj] = *(const f32x4*)(basef + row * ldf + col); b1[m][bj] = *(const f32x4*)(basef + row * ldf + col + 4); }
                    else { const u32x4 w = *(const u32x4*)(xb + row * ldb + col);
                        b0[m][bj] = (f32x4){bf_lo(w.x), bf_hi(w.x), bf_lo(w.y), bf_hi(w.y)}; b1[m][bj] = (f32x4){bf_lo(w.z), bf_hi(w.z), bf_lo(w.w), bf_hi(w.w)}; } } }
#pragma unroll
            for (int m = 0; m < 4; ++m) { const size_t row = (size_t)(u.pm * BM + ai * HALF + wr * 64 + m * 16 + fr);
#pragma unroll
                for (int bj = 0; bj < 2; ++bj) { const f32x4 v0 = b0[m][bj] + acc[ai][bj][m][0], v1 = b1[m][bj] + acc[ai][bj][m][1];
                    u32x4 w; w.x = cvt_pk_bf16(v0[0], v0[1]); w.y = cvt_pk_bf16(v0[2], v0[3]); w.z = cvt_pk_bf16(v1[0], v1[1]); w.w = cvt_pk_bf16(v1[2], v1[3]);
                    *(u32x4*)(xb + row * ldb + col0 + bj * HALF) = w; } }
        }
    }
};
using EpiResBf = EpiResBfT<false>; using EpiResBf8 = EpiResBfT<true>;
struct EpiSwiglu {
    static constexpr bool STAGE = false; static constexpr bool PERM = true, PERMV = false, AFTER_DRAIN = false;
    bf16_t* O; int ldo;
    __device__ __forceinline__ void operator()(const f32x4 (&acc)[2][2][4][2], const Unit& u, int wr, int wc, int fr, int fq) const {
        const int row0 = u.pm * BM + wr * 64 + fr, col0 = u.pn * HALF + wc * 32 + 8 * fq;
#pragma unroll
        for (int ai = 0; ai < 2; ++ai)
#pragma unroll
            for (int m = 0; m < 4; ++m) { bf16_t* op = O + (size_t)(row0 + ai * HALF + m * 16) * ldo + col0;
                f32x4 h0, h1;
#pragma unroll
                for (int j = 0; j < 4; ++j) { const float g0 = acc[ai][0][m][0][j], g1 = acc[ai][0][m][1][j];
                    h0[j] = g0 * sigmoid_f(g0) * acc[ai][1][m][0][j]; h1[j] = g1 * sigmoid_f(g1) * acc[ai][1][m][1][j]; }
                u32x4 w; w.x = cvt_pk_bf16(h0[0], h0[1]); w.y = cvt_pk_bf16(h0[2], h0[3]); w.z = cvt_pk_bf16(h1[0], h1[1]); w.w = cvt_pk_bf16(h1[2], h1[3]);
                *(u32x4*)op = w; }
    }
};
struct EpiMoeScatter {
    static constexpr bool STAGE = false; static constexpr bool PERM = false, PERMV = false, AFTER_DRAIN = false;
    float* out; int ldc; const int* slot_tok; const float* slot_w; int slot0;
    __device__ __forceinline__ void operator()(const f32x4 (&acc)[2][2][4][2], const Unit& u, int wr, int wc, int fr, int fq) const {
        const int col0 = u.pn * BM + wc * 32 + 4 * fq;
#pragma unroll
        for (int ai = 0; ai < 2; ++ai)
#pragma unroll
            for (int m = 0; m < 4; ++m) { const int slot = slot0 + u.pm * BM + ai * HALF + wr * 64 + m * 16 + fr;
                const int tok = slot_tok[slot]; const float w = slot_w[slot];
                if (tok >= 0) { float* op = out + (size_t)tok * ldc + col0;
#pragma unroll
                    for (int bj = 0; bj < 2; ++bj)
#pragma unroll
                        for (int n = 0; n < 2; ++n) { const f32x4 v = acc[ai][bj][m][n] * w; float* p = op + bj * HALF + n * 16;
                            unsafeAtomicAdd(p + 0, v[0]); unsafeAtomicAdd(p + 1, v[1]); unsafeAtomicAdd(p + 2, v[2]); unsafeAtomicAdd(p + 3, v[3]); } } }
    }
};
struct EpiMoeStore {
    static constexpr bool STAGE = false; static constexpr bool PERM = true, PERMV = false, AFTER_DRAIN = false;
    bf16_t* O; int ldo; const float* slot_w; int slot0; float ascale;
    __device__ __forceinline__ void operator()(const f32x4 (&acc)[2][2][4][2], const Unit& u, int wr, int wc, int fr, int fq) const {
        const int row0 = slot0 + u.pm * BM + wr * 64 + fr, col0 = u.pn * BM + wc * 32 + 8 * fq;
        float wv[2][4];
#pragma unroll
        for (int ai = 0; ai < 2; ++ai)
#pragma unroll
            for (int m = 0; m < 4; ++m) wv[ai][m] = slot_w[row0 + ai * HALF + m * 16];
#pragma unroll
        for (int ai = 0; ai < 2; ++ai)
#pragma unroll
            for (int m = 0; m < 4; ++m) wv[ai][m] *= ascale;
#pragma unroll
        for (int ai = 0; ai < 2; ++ai)
#pragma unroll
            for (int m = 0; m < 4; ++m) { const int slot = row0 + ai * HALF + m * 16; const float w = wv[ai][m]; bf16_t* rowp = O + (size_t)slot * ldo + col0;
#pragma unroll
                for (int bj = 0; bj < 2; ++bj) { const f32x4 v0 = acc[ai][bj][m][0] * w, v1 = acc[ai][bj][m][1] * w;
                    u32x4 o; o.x = cvt_pk_bf16(v0[0], v0[1]); o.y = cvt_pk_bf16(v0[2], v0[3]); o.z = cvt_pk_bf16(v1[0], v1[1]); o.w = cvt_pk_bf16(v1[2], v1[3]);
                    *(u32x4*)(rowp + bj * HALF) = o; } }
    }
};
struct EpiSwiglu8 {
    static constexpr bool STAGE = false; static constexpr bool PERM = true, PERMV = false, AFTER_DRAIN = false;
    unsigned char* O; int ldo; float ascale;
    __device__ __forceinline__ void operator()(const f32x4 (&acc)[2][2][4][2], const Unit& u, int wr, int wc, int fr, int fq) const {
        const int row0 = u.pm * BM + wr * 64 + fr, col0 = u.pn * HALF + wc * 32 + 8 * fq;
        const float k1 = -1.4426950408889634f * ascale, ic = 1.f / (ascale * ascale), lc = __builtin_amdgcn_logf(ic);
#pragma unroll
        for (int ai = 0; ai < 2; ++ai)
#pragma unroll
            for (int m = 0; m < 4; ++m) { unsigned char* op = O + (size_t)(row0 + ai * HALF + m * 16) * ldo + col0;
                float e[8], t[8];
#pragma unroll
                for (int j = 0; j < 4; ++j) { const float ga = acc[ai][0][m][0][j], gb = acc[ai][0][m][1][j];
                    e[j] = __builtin_amdgcn_exp2f(__builtin_fmaf(ga, k1, lc)); e[4 + j] = __builtin_amdgcn_exp2f(__builtin_fmaf(gb, k1, lc));
                    t[j] = ga * acc[ai][1][m][0][j]; t[4 + j] = gb * acc[ai][1][m][1][j]; }
#pragma unroll
                for (int j = 0; j < 8; ++j) e[j] = __builtin_amdgcn_rcpf(e[j] + ic);
#pragma unroll
                for (int j = 0; j < 8; ++j) t[j] *= e[j];
                typedef unsigned u32x2 __attribute__((ext_vector_type(2)));
                __hip_atomic_store((unsigned long long*)op, (unsigned long long)pack4_f8(t[0], t[1], t[2], t[3]) | ((unsigned long long)pack4_f8(t[4], t[5], t[6], t[7]) << 32), __ATOMIC_RELAXED, __HIP_MEMORY_SCOPE_AGENT); }
    }
};
struct EpiResF32S {
    static constexpr bool STAGE = false; static constexpr bool PERM = false, PERMV = false, AFTER_DRAIN = false;
    const float* base; float* out; int ldc; float ascale;
    __device__ __forceinline__ void operator()(const f32x4 (&acc)[2][2][4][2], const Unit& u, int wr, int wc, int fr, int fq) const {
        const int col0 = u.pn * BM + wc * 32 + 4 * fq;
#pragma unroll
        for (int ai = 0; ai < 2; ++ai)
#pragma unroll
            for (int m = 0; m < 4; ++m) { const size_t off = (size_t)(u.pm * BM + ai * HALF + wr * 64 + m * 16 + fr) * ldc + col0;
#pragma unroll
                for (int bj = 0; bj < 2; ++bj)
#pragma unroll
                    for (int n = 0; n < 2; ++n) { const f32x4 bs = *(const f32x4*)(base + off + bj * HALF + n * 16); *(f32x4*)(out + off + bj * HALF + n * 16) = bs + acc[ai][bj][m][n] * ascale; } }
    }
};
typedef int i32x4_t __attribute__((ext_vector_type(4)));
__device__ __forceinline__ f32x4 acc_i2f(const f32x4& a, float s) { return __builtin_convertvector(__builtin_bit_cast(i32x4_t, a), f32x4) * s; }
__device__ __forceinline__ f32x4 acc_i2f_again(const f32x4& a, float s) { i32x4_t t = __builtin_bit_cast(i32x4_t, a); asm volatile("" : "+v"(t)); return __builtin_convertvector(t, f32x4) * s; }
template <int ACT> struct EpiStoreBf16Q {
    static constexpr bool STAGE = false; static constexpr bool PERM = true, PERMV = false, AFTER_DRAIN = false;
    bf16_t* O; int ldc; const float* bias; const float* sa; const float* swc;
    __device__ __forceinline__ void operator()(const f32x4 (&acc)[2][2][4][2], const Unit& u, int wr, int wc, int fr, int fq) const {
        const int row0 = u.pm * BM + wr * 64 + fr, col0 = u.pn * BM + wc * 32 + 8 * fq;
        f32x4 bv[2][2], cs[2][2]; float rsv[2][4];
#pragma unroll
        for (int bj = 0; bj < 2; ++bj)
#pragma unroll
            for (int n = 0; n < 2; ++n) { bv[bj][n] = bias ? *(const f32x4*)(bias + col0 + bj * HALF + 4 * n) : (f32x4){0.f, 0.f, 0.f, 0.f}; cs[bj][n] = *(const f32x4*)(swc + col0 + bj * HALF + 4 * n); }
#pragma unroll
        for (int ai = 0; ai < 2; ++ai)
#pragma unroll
            for (int m = 0; m < 4; ++m) rsv[ai][m] = sa[row0 + ai * HALF + m * 16];
#pragma unroll
        for (int ai = 0; ai < 2; ++ai)
#pragma unroll
            for (int m = 0; m < 4; ++m) { const int row = row0 + ai * HALF + m * 16; bf16_t* rowp = O + (size_t)row * ldc + col0; const float rs = rsv[ai][m];
#pragma unroll
                for (int bj = 0; bj < 2; ++bj) { f32x4 v0 = acc_i2f(acc[ai][bj][m][0], rs) * cs[bj][0] + bv[bj][0], v1 = acc_i2f(acc[ai][bj][m][1], rs) * cs[bj][1] + bv[bj][1];
                    if (ACT == 2) {
#pragma unroll
                        for (int j = 0; j < 4; ++j) { v0[j] = sigmoid_f(v0[j]); v1[j] = sigmoid_f(v1[j]); } }
                    u32x4 w; w.x = cvt_pk_bf16(v0[0], v0[1]); w.y = cvt_pk_bf16(v0[2], v0[3]); w.z = cvt_pk_bf16(v1[0], v1[1]); w.w = cvt_pk_bf16(v1[2], v1[3]);
                    *(u32x4*)(rowp + bj * HALF) = w; } }
    }
};
template <bool F8OUT> struct EpiSwigluQT {
    static constexpr bool STAGE = F8OUT; static constexpr bool PERM = true, PERMV = false, AFTER_DRAIN = false;
    bf16_t* O; int ldo; const float* sa; const float* swg; const float* swu; PG8_LAS float* ls;
    __device__ __forceinline__ void stage(const Unit& u, int wid, int lane) const {
        const float* src = wid < 4 ? sa + u.pm * BM + 64 * wid : (wid < 6 ? swg + u.pn * HALF + 64 * (wid - 4) : swu + u.pn * HALF + 64 * (wid - 6));
        __builtin_amdgcn_global_load_lds((const unsigned*)(src + lane), (PG8_LAS unsigned*)(ls + u.par * 512 + 64 * wid), 4, 0, 0);
    }
    __device__ __forceinline__ void operator()(const f32x4 (&acc)[2][2][4][2], const Unit& u, int wr, int wc, int fr, int fq) const {
        const int row0 = u.pm * BM + wr * 64 + fr, col0 = u.pn * HALF + wc * 32 + 8 * fq;
        f32x4 g0s, g1s, u0s, u1s; float rsv[2][4];
        if constexpr (STAGE) {
            int db = u.par * 512; asm volatile("" : "+v"(db));
            const PG8_LAS float* d = ls + db;
            g0s = *(const PG8_LAS f32x4*)(d + 256 + wc * 32 + 8 * fq); g1s = *(const PG8_LAS f32x4*)(d + 256 + wc * 32 + 8 * fq + 4);
            u0s = *(const PG8_LAS f32x4*)(d + 384 + wc * 32 + 8 * fq); u1s = *(const PG8_LAS f32x4*)(d + 384 + wc * 32 + 8 * fq + 4);
#pragma unroll
            for (int ai = 0; ai < 2; ++ai)
#pragma unroll
                for (int m = 0; m < 4; ++m) rsv[ai][m] = d[wr * 64 + fr + ai * HALF + m * 16];
        } else {
        g0s = *(const f32x4*)(swg + col0); g1s = *(const f32x4*)(swg + col0 + 4); u0s = *(const f32x4*)(swu + col0); u1s = *(const f32x4*)(swu + col0 + 4);
#pragma unroll
        for (int ai = 0; ai < 2; ++ai)
#pragma unroll
            for (int m = 0; m < 4; ++m) rsv[ai][m] = sa[row0 + ai * HALF + m * 16];
        }
#pragma unroll
        for (int ai = 0; ai < 2; ++ai)
#pragma unroll
            for (int m = 0; m < 4; ++m) { const int row = row0 + ai * HALF + m * 16; bf16_t* op = O + (size_t)row * ldo + col0; const float rs = rsv[ai][m];
                const f32x4 ga = acc_i2f(acc[ai][0][m][0], rs) * g0s, gb = acc_i2f(acc[ai][0][m][1], rs) * g1s, ua = acc_i2f(acc[ai][1][m][0], rs) * u0s, ub = acc_i2f(acc[ai][1][m][1], rs) * u1s;
                f32x4 h0, h1;
#pragma unroll
                for (int j = 0; j < 4; ++j) { h0[j] = ga[j] * sigmoid_f(ga[j]) * ua[j]; h1[j] = gb[j] * sigmoid_f(gb[j]) * ub[j]; }
                if constexpr (F8OUT) { typedef unsigned u32x2 __attribute__((ext_vector_type(2)));
                    *(u32x2*)((unsigned char*)O + (size_t)row * ldo + col0) = (u32x2){pack4_f8(h0[0], h0[1], h0[2], h0[3]), pack4_f8(h1[0], h1[1], h1[2], h1[3])}; }
                else { u32x4 w; w.x = cvt_pk_bf16(h0[0], h0[1]); w.y = cvt_pk_bf16(h0[2], h0[3]); w.z = cvt_pk_bf16(h1[0], h1[1]); w.w = cvt_pk_bf16(h1[2], h1[3]);
                    *(u32x4*)op = w; } }
    }
};
using EpiSwigluQ = EpiSwigluQT<false>; using EpiSwigluQ8 = EpiSwigluQT<true>;

template <class Epi, class Sched, bool ALIGN_EPI = false, bool SP2 = false, int QM = 0>
__device__ __forceinline__ void gemm_phase(PG8_LAS unsigned char* lds, const Gemm g, const Sched& S, const Epi& E) {
    constexpr bool F8 = (QM == 1), I8 = (QM == 2);
    int tid_ = cur_tid();
    const int tid = tid_, wid = __builtin_amdgcn_readfirstlane(tid >> 6), lane = tid & 63, wr = wid >> 2, wc = wid & 3, fr = lane & 15, fq = lane >> 4;
    const int K = g.K, nt = K / BK;
    unsigned voffA[2], voffB[2];
#pragma unroll
    for (int i = 0; i < 2; ++i) { int R, C; stage_rc(tid * 16 + i * 8192, R, C); const int Rb = Epi::PERM ? ((R & ~31) + perm32(R & 31)) : (Epi::PERMV ? ((R & ~31) + permv32(R & 31)) : R);
        voffA[i] = (unsigned)(R * g.lda + C) * 2u; voffB[i] = (unsigned)(Rb * K + C) * 2u; }
    const size_t kstep = (size_t)(BK * 2);
    const size_t hstepA = (size_t)HALF * g.lda * 2, hstepB = (size_t)HALF * K * 2;
    const unsigned ldsw = (unsigned)wid * 1024u;
    const int aoff = lds_byte(wr * 64 + fr, fq * 8), boff = lds_byte(wc * 32 + fr, fq * 8);
#define PG8_SA(b, h) (((b) * 2 + (h)) * HTB)
#define PG8_SB(b, h) ((4 + (b) * 2 + (h)) * HTB)
#define PG8_STAGE(bufoff, gbase, voff) do { _Pragma("unroll") for (int _i = 0; _i < 2; ++_i) \
        __builtin_amdgcn_global_load_lds((const unsigned*)((const char*)(gbase) + (voff)[_i]), (PG8_LAS unsigned*)(lds + (bufoff) + ldsw + _i * 8192), 16, 0, 0); } while (0)
#define PG8_LDA(dst, b, h) do { if constexpr (F8) { _Pragma("unroll") for (int m = 0; m < 4; ++m) { dst##8[m].lo = *(const PG8_LAS v4i_t*)(lds + PG8_SA(b, h) + aoff + m * 2048); dst##8[m].hi = *(const PG8_LAS v4i_t*)(lds + PG8_SA(b, h) + aoff + m * 2048 + 1024); } } \
    else { _Pragma("unroll") for (int m = 0; m < 4; ++m) _Pragma("unroll") for (int k = 0; k < 2; ++k) dst[m][k] = *(const PG8_LAS bf16x8*)(lds + PG8_SA(b, h) + aoff + m * 2048 + k * 1024); } } while (0)
#define PG8_LDB(dst, b, h) do { if constexpr (F8) { _Pragma("unroll") for (int n = 0; n < 2; ++n) { dst##8[n].lo = *(const PG8_LAS v4i_t*)(lds + PG8_SB(b, h) + boff + n * 2048); dst##8[n].hi = *(const PG8_LAS v4i_t*)(lds + PG8_SB(b, h) + boff + n * 2048 + 1024); } } \
    else { _Pragma("unroll") for (int n = 0; n < 2; ++n) _Pragma("unroll") for (int k = 0; k < 2; ++k) dst[n][k] = *(const PG8_LAS bf16x8*)(lds + PG8_SB(b, h) + boff + n * 2048 + k * 1024); } } while (0)
#define PG8_MMA(ai, bj, At, Bt) do { __builtin_amdgcn_s_setprio(1); if constexpr (F8) { _Pragma("unroll") for (int m = 0; m < 4; ++m) _Pragma("unroll") for (int n = 0; n < 2; ++n) \
        mfma_f8_acc(acc[ai][bj][m][n], Bt##8[n], At##8[m], f8_one); } \
    else if constexpr (I8) { _Pragma("unroll") for (int m = 0; m < 4; ++m) _Pragma("unroll") for (int n = 0; n < 2; ++n) _Pragma("unroll") for (int k = 0; k < 2; ++k) \
        acc[ai][bj][m][n] = __builtin_bit_cast(f32x4, __builtin_amdgcn_mfma_i32_16x16x64_i8(__builtin_bit_cast(v4i_t, Bt[n][k]), __builtin_bit_cast(v4i_t, At[m][k]), __builtin_bit_cast(v4i_t, acc[ai][bj][m][n]), 0, 0, 0)); } \
    else { _Pragma("unroll") for (int m = 0; m < 4; ++m) _Pragma("unroll") for (int n = 0; n < 2; ++n) _Pragma("unroll") for (int k = 0; k < 2; ++k) \
        acc[ai][bj][m][n] = __builtin_amdgcn_mfma_f32_16x16x32_bf16(Bt[n][k], At[m][k], acc[ai][bj][m][n], 0, 0, 0); } __builtin_amdgcn_s_setprio(0); } while (0)
#define PG8_UNI(p_) ((const char*)(((unsigned long long)(unsigned)__builtin_amdgcn_readfirstlane((unsigned)((unsigned long long)(p_) >> 32)) << 32) | (unsigned)__builtin_amdgcn_readfirstlane((unsigned)(unsigned long long)(p_))))
#define PG8_WAIT_V(n) asm volatile("s_waitcnt vmcnt(" #n ")" ::: "memory")
#define PG8_WAIT_L(n) asm volatile("s_waitcnt lgkmcnt(" #n ")" ::: "memory")
#define PG8_BAR __builtin_amdgcn_s_barrier()
#define PG8_SCHED __builtin_amdgcn_sched_barrier(0)
    Unit cur, nxt; int ui = 0;
    if (!S.next(0, cur)) return;
    f32x4 acc[2][2][4][2];
#pragma unroll
    for (int a = 0; a < 2; ++a)
#pragma unroll
        for (int b = 0; b < 2; ++b)
#pragma unroll
            for (int m = 0; m < 4; ++m)
#pragma unroll
                for (int n = 0; n < 2; ++n) acc[a][b][m][n] = (f32x4){0.f, 0.f, 0.f, 0.f};
    bf16x8 At[4][2], B0[2][2], B1[2][2];
    v8i_t At8[4], B08[2], B18[2];
    const char* cA = S.a_ptr(g, cur); const char* cB = S.b_ptr(g, cur);
    S.a_ready(cur);
    if constexpr (SP2) {
        PG8_STAGE(PG8_SB(0, 0), cB, voffB); PG8_STAGE(PG8_SB(0, 1), cB + hstepB, voffB); PG8_STAGE(PG8_SA(0, 0), cA, voffA); PG8_STAGE(PG8_SA(0, 1), cA + hstepA, voffA);
        if (wr == 1) PG8_BAR;
        PG8_WAIT_V(2); PG8_BAR;
        PG8_STAGE(PG8_SB(1, 0), cB + kstep, voffB); PG8_STAGE(PG8_SA(1, 0), cA + kstep, voffA); PG8_STAGE(PG8_SB(1, 1), cB + hstepB + kstep, voffB);
        PG8_WAIT_V(6); PG8_BAR;
    } else {
        PG8_STAGE(PG8_SB(0, 0), cB, voffB); PG8_STAGE(PG8_SA(0, 0), cA, voffA); PG8_STAGE(PG8_SB(0, 1), cB + hstepB, voffB); PG8_STAGE(PG8_SA(0, 1), cA + hstepA, voffA);
        if (wr == 1) PG8_BAR;
        PG8_WAIT_V(4); PG8_BAR;
        PG8_STAGE(PG8_SB(1, 0), cB + kstep, voffB); PG8_STAGE(PG8_SA(1, 0), cA + kstep, voffA); PG8_STAGE(PG8_SB(1, 1), cB + hstepB + kstep, voffB);
        PG8_WAIT_V(6); PG8_BAR;
    }
    int f8_one = 0x7f7f7f7f; asm volatile("" : "+v"(f8_one));
    for (;;) {
        cur.par = ui & 1;
        if constexpr (Epi::STAGE) E.stage(cur, wid, lane);
        const bool has_next = S.next(ui + 1, nxt);
        const char* nA = has_next ? S.a_ptr(g, nxt) : cA; const char* nB = has_next ? S.b_ptr(g, nxt) : cB;
        for (int t = 0; t < nt; t += 2) {
            const bool last = (t == nt - 2);
            const char* a1 = PG8_UNI(cA + (size_t)(t + 1) * kstep);
            const char* a2 = PG8_UNI(last ? nA : cA + (size_t)(t + 2) * kstep); const char* b2 = PG8_UNI(last ? nB : cB + (size_t)(t + 2) * kstep);
            const char* a3 = a2 + kstep; const char* b3 = b2 + kstep;
            if (last && has_next) S.a_ready(nxt);
            if constexpr (SP2) {
            PG8_LDB(B0, 0, 0); PG8_LDB(B1, 0, 1); PG8_SCHED; PG8_LDA(At, 0, 0); PG8_STAGE(PG8_SA(1, 1), a1 + hstepA, voffA);
            PG8_WAIT_V(8); PG8_WAIT_L(0); PG8_BAR; PG8_MMA(0, 0, At, B0); PG8_MMA(0, 1, At, B1); PG8_BAR; PG8_SCHED;
            PG8_LDA(At, 0, 1); PG8_STAGE(PG8_SB(0, 0), b2, voffB); PG8_STAGE(PG8_SB(0, 1), b2 + hstepB, voffB);
            PG8_WAIT_V(6); PG8_WAIT_L(0); PG8_BAR; PG8_MMA(1, 0, At, B0); PG8_SCHED; PG8_STAGE(PG8_SA(0, 0), a2, voffA); PG8_SCHED; PG8_MMA(1, 1, At, B1); PG8_BAR; PG8_SCHED;
            PG8_LDB(B0, 1, 0); PG8_LDB(B1, 1, 1); PG8_SCHED; PG8_LDA(At, 1, 0); PG8_STAGE(PG8_SA(0, 1), a2 + hstepA, voffA);
            PG8_WAIT_V(8); PG8_WAIT_L(0); PG8_BAR; PG8_MMA(0, 0, At, B0); PG8_MMA(0, 1, At, B1); PG8_BAR; PG8_SCHED;
            PG8_LDA(At, 1, 1); PG8_STAGE(PG8_SB(1, 0), b3, voffB); PG8_STAGE(PG8_SB(1, 1), b3 + hstepB, voffB);
            PG8_WAIT_V(6); PG8_WAIT_L(0); PG8_BAR; PG8_MMA(1, 0, At, B0); PG8_SCHED; PG8_STAGE(PG8_SA(1, 0), a3, voffA); PG8_SCHED; PG8_MMA(1, 1, At, B1); PG8_BAR; PG8_SCHED;
            } else {
            PG8_LDB(B0, 0, 0); PG8_SCHED; PG8_LDA(At, 0, 0); PG8_STAGE(PG8_SA(1, 1), a1 + hstepA, voffA);
            PG8_WAIT_L(8); PG8_BAR; PG8_WAIT_L(0); PG8_MMA(0, 0, At, B0); PG8_BAR; PG8_SCHED;
            PG8_LDB(B1, 0, 1); PG8_STAGE(PG8_SB(0, 0), b2, voffB);
            PG8_BAR; PG8_WAIT_L(0); PG8_MMA(0, 1, At, B1); PG8_BAR;
            PG8_LDA(At, 0, 1); PG8_STAGE(PG8_SA(0, 0), a2, voffA);
            PG8_BAR; PG8_WAIT_L(0); PG8_MMA(1, 0, At, B0); PG8_BAR; PG8_SCHED;
            PG8_STAGE(PG8_SB(0, 1), b2 + hstepB, voffB);
            PG8_WAIT_V(6); PG8_BAR; PG8_MMA(1, 1, At, B1); PG8_BAR;
            PG8_LDB(B0, 1, 0); PG8_SCHED; PG8_LDA(At, 1, 0); PG8_STAGE(PG8_SA(0, 1), a2 + hstepA, voffA);
            PG8_WAIT_L(8); PG8_BAR; PG8_WAIT_L(0); PG8_MMA(0, 0, At, B0); PG8_BAR; PG8_SCHED;
            PG8_LDB(B1, 1, 1); PG8_STAGE(PG8_SB(1, 0), b3, voffB);
            PG8_BAR; PG8_WAIT_L(0); PG8_MMA(0, 1, At, B1); PG8_BAR;
            PG8_LDA(At, 1, 1); PG8_STAGE(PG8_SA(1, 0), a3, voffA);
            PG8_BAR; PG8_WAIT_L(0); PG8_MMA(1, 0, At, B0); PG8_BAR; PG8_SCHED;
            PG8_STAGE(PG8_SB(1, 1), b3 + hstepB, voffB);
            PG8_WAIT_V(6); PG8_BAR; PG8_MMA(1, 1, At, B1); PG8_BAR;
            }
        }
        if constexpr (F8) asm volatile("s_nop 15\n\ts_nop 7" ::: "memory");
        if constexpr (ALIGN_EPI) { if (wr == 0) PG8_BAR; }
        if constexpr (!Epi::AFTER_DRAIN) { E(acc, cur, wr, wc, fr, fq); S.done(cur); }
        if (!has_next) break;
#pragma unroll
        for (int a = 0; a < 2; ++a)
#pragma unroll
            for (int b = 0; b < 2; ++b)
#pragma unroll
                for (int m = 0; m < 4; ++m)
#pragma unroll
                    for (int n = 0; n < 2; ++n) acc[a][b][m][n] = (f32x4){0.f, 0.f, 0.f, 0.f};
        cur = nxt; cA = nA; cB = nB; ++ui;
        if constexpr (ALIGN_EPI) { if (wr == 1) PG8_BAR; }
    }
    PG8_WAIT_V(0);
    if constexpr (!ALIGN_EPI) { if (wr == 0) PG8_BAR; }
    PG8_BAR;
    if constexpr (Epi::AFTER_DRAIN) { E.fused(acc, cur, wr, wc, fr, fq, lds, wid, lane); S.done(cur); }
#undef PG8_SA
#undef PG8_SB
#undef PG8_STAGE
#undef PG8_LDA
#undef PG8_LDB
#undef PG8_MMA
#undef PG8_WAIT_V
#undef PG8_WAIT_L
#undef PG8_BAR
#undef PG8_SCHED
}
}

constexpr int NWAVES = 8;
constexpr int BATCH = 4, SEQ = 8192, D = 1024, M = BATCH * SEQ;
constexpr int INW = 3072, C_SBQ = 0, C_SBK = 512, C_SBV = 1024, C_DFQ = 1536, C_DFK = 2048, C_DFV = 2560;
constexpr int GATEW = 2048, DFF = 2816, NEXP = 8, DFE = 3584;
constexpr float NORM_EPS = 1e-6f;
constexpr int MOE_MAX_TILES = 2 * M / 256 + NEXP, MOE_CHUNK_TILES = MOE_MAX_TILES, MOE_MAX_CHUNKS = (MOE_MAX_TILES + MOE_CHUNK_TILES - 1) / MOE_CHUNK_TILES;

constexpr size_t MiB = 1u << 20;
constexpr size_t WS_CTL = 0, CTL_ZERO_BYTES = 1 * MiB;
constexpr size_t WS_WT = 1 * MiB;
constexpr size_t WT_LAYER = 14 * MiB, WT_WIN = 0, WT_WG = 6 * MiB, WT_WSB = 10 * MiB, WT_WDF = 11 * MiB, WT_WOUT = 12 * MiB;
constexpr size_t WS_WGU = 29 * MiB, WS_WDOWN = 40 * MiB;
constexpr size_t WS_MOE13 = 494 * MiB, WS_MOE2 = 206 * MiB;
constexpr size_t MOE13_EXP = 7 * MiB, MOE2_EXP = 7 * MiB / 2;
constexpr size_t WS_FRAG = 46 * MiB;
constexpr size_t WS_H = 174 * MiB;
constexpr size_t WS_Y = 238 * MiB;
constexpr size_t WS_PROJ = 302 * MiB;
constexpr size_t WS_GATES = WS_PROJ, WS_MERGED = WS_PROJ + 128 * MiB, WS_HID = WS_PROJ;
constexpr size_t WS_XS = 1 * MiB;
constexpr size_t WS_YS = 67 * MiB;
constexpr size_t WS_HIDC = 238 * MiB;
constexpr size_t WS_LTOK = 234 * MiB, WS_LW = 235 * MiB, WS_STOK = 236 * MiB, WS_SW = 236 * MiB + 512 * 1024;
constexpr size_t WS_SA = 237 * MiB, WS_PMAX = 237 * MiB + 256 * 1024, WS_SWC = 237 * MiB + 832 * 1024;
constexpr size_t WS_END = 550 * MiB;
static_assert(WS_WDOWN + (size_t)D * DFF * 2 <= WS_FRAG && WS_H + (size_t)M * D <= WS_MOE2 && WS_MOE2 + 8 * MOE2_EXP <= WS_LTOK && WS_SWC + 15872 * 4 <= WS_Y && WS_PROJ + (size_t)M * INW * 2 <= WS_MOE13 && WS_MOE13 + 8 * MOE13_EXP <= WS_END, "ws map");
static_assert(WS_XS + (size_t)MOE_MAX_TILES * 256 * D <= WS_YS && WS_YS + (size_t)MOE_MAX_TILES * 256 * D * 2 <= WS_MOE2 && WS_HIDC + (size_t)MOE_CHUNK_TILES * 256 * DFE <= WS_MOE13 && WS_HID + (size_t)M * DFF * 2 <= WS_MOE13 && (size_t)MOE_MAX_TILES * 256 * 4 <= 512 * 1024, "ws map 2");
constexpr float SC_W13 = 64.f, SC_W2 = 128.f;
constexpr int CW_BAR = 4096;
constexpr int CW_WMAX = 10240;
constexpr int CW_CNT = 8192;

constexpr int RING_OFF = 0, RING_BYTES = 131072;
constexpr int LDSCTL_OFF = RING_BYTES, MISC_OFF = LDSCTL_OFF + 320, PLAN_OFF = LDSCTL_OFF + 1024;
constexpr int LDS_BYTES = 147456;

#define GAS __attribute__((address_space(1)))
#define LAS __attribute__((address_space(3)))
typedef unsigned short bf16;
typedef unsigned v4u __attribute__((ext_vector_type(4)));
typedef unsigned v2u __attribute__((ext_vector_type(2)));
typedef float f32x4 __attribute__((ext_vector_type(4)));
typedef GAS unsigned gu32;
#define RLX_AGENT __ATOMIC_RELAXED, __HIP_MEMORY_SCOPE_AGENT
#define LDS_WAIT() asm volatile("s_waitcnt lgkmcnt(0)" ::: "memory")
#define VM_WAIT() asm volatile("s_waitcnt vmcnt(0)" ::: "memory")
__device__ __forceinline__ unsigned f2bf(float f) { unsigned u = __builtin_bit_cast(unsigned, f); return (u + 0x7fffu + ((u >> 16) & 1u)) >> 16; }
__device__ __forceinline__ unsigned pk2(float lo, float hi) { return f2bf(lo) | (f2bf(hi) << 16); }
__device__ __forceinline__ float bflo(unsigned w) { return __uint_as_float(w << 16); }
__device__ __forceinline__ float bfhi(unsigned w) { return __uint_as_float(w & 0xffff0000u); }
__device__ __forceinline__ float bf2f(bf16 b) { return __uint_as_float((unsigned)b << 16); }
#define XB_TMO      128
#define XB_XCNT(j)  (256  + 64 * (j))
#define XB_XSUB(j)  (1280 + 64 * (j))
#define XB_XGEN(j)  (2304 + 64 * (j))
#define XB_TOP      3328
#define XB_TOPGEN   3392
#define XCD_BAR_WORDS 3456
#define XB_SPIN_CAP (1u << 18)

__device__ __forceinline__ unsigned xb_ld(unsigned* p)              { return __hip_atomic_load(p, __ATOMIC_RELAXED, __HIP_MEMORY_SCOPE_AGENT); }
__device__ __forceinline__ unsigned xb_add(unsigned* p, unsigned v) { return __hip_atomic_fetch_add(p, v, __ATOMIC_RELAXED, __HIP_MEMORY_SCOPE_AGENT); }
__device__ __forceinline__ unsigned xb_xcc_id() { return (unsigned)__builtin_amdgcn_s_getreg((3 << 11) | 20) & 0xFu; }
#define XB_SPIN(cond, bar) do { unsigned _sp = 0; while (cond) { __builtin_amdgcn_s_sleep(1); \
    if ((++_sp & 255u) == 0u) { if (xb_ld(&(bar)[XB_TMO])) break; if (_sp > XB_SPIN_CAP) { atomicAdd(&(bar)[XB_TMO], 1u); break; } } } } while (0)

struct XcdBarrier {
    unsigned* bar; unsigned x;
    volatile LAS unsigned* st;
};

__device__ __forceinline__ XcdBarrier xcd_barrier_post(unsigned* bar, volatile LAS unsigned* st) {
    XcdBarrier b; b.bar = bar; b.x = xb_xcc_id(); b.st = st;
    if (cur_tid() == 0) (void)xb_add(&bar[XB_XCNT(b.x)], 1u);
    return b;
}
__device__ __forceinline__ void xcd_barrier_complete(unsigned* bar, unsigned x, unsigned& nloc, unsigned& nx) {
    const unsigned G = gridDim.x * gridDim.y * gridDim.z;
    unsigned sum, cnt, mine, sp = 0u;
    for (;;) {
        sum = 0u; cnt = 0u; mine = 0u;
#pragma unroll
        for (unsigned j = 0; j < 16; ++j) { const unsigned c = xb_ld(&bar[XB_XCNT(j)]); sum += c; cnt += (c > 0u) ? 1u : 0u; mine = (j == x) ? c : mine; }
        if (sum == G) break;
        __builtin_amdgcn_s_sleep(1);
        if ((++sp & 255u) == 0u) { if (xb_ld(&bar[XB_TMO])) break; if (sp > XB_SPIN_CAP) { atomicAdd(&bar[XB_TMO], 1u); break; } }
    }
    nloc = mine > 0u ? mine : 1u; nx = cnt > 0u ? cnt : 1u;
}

__device__ __forceinline__ void xcd_barrier(const XcdBarrier& b) {
    asm volatile("s_waitcnt vmcnt(0)" ::: "memory");
    __syncthreads();
    if (cur_tid() == 0) {
        unsigned* bar = b.bar;
        __builtin_amdgcn_s_waitcnt(0);
        unsigned nloc = b.st[0], nx = b.st[1];
        if (nloc == 0u) { xcd_barrier_complete(bar, b.x, nloc, nx); b.st[0] = nloc; b.st[1] = nx; }
        const unsigned old = xb_add(&bar[XB_XSUB(b.x)], 1u);
        const unsigned gen = old / nloc;
        if (old + 1u == (gen + 1u) * nloc) {
            __builtin_amdgcn_fence(__ATOMIC_RELEASE, "agent");
            asm volatile("s_waitcnt vmcnt(0)" ::: "memory");
            const unsigned og = xb_add(&bar[XB_TOP], 1u);
            const unsigned tg = og / nx;
            if (og + 1u == (tg + 1u) * nx) xb_add(&bar[XB_TOPGEN], 1u);
            else XB_SPIN(xb_ld(&bar[XB_TOPGEN]) == tg, bar);
            __builtin_amdgcn_fence(__ATOMIC_ACQUIRE, "agent");
            xb_add(&bar[XB_XGEN(b.x)], 1u);
            asm volatile("s_waitcnt vmcnt(0)" ::: "memory");
        } else {
            XB_SPIN(xb_ld(&bar[XB_XGEN(b.x)]) == gen, bar);
            __builtin_amdgcn_fence(__ATOMIC_ACQUIRE, "agent");
            asm volatile("s_waitcnt vmcnt(0)" ::: "memory");
        }
    }
    __syncthreads();
}

struct Frame {
    LAS unsigned char* lds;
    volatile LAS unsigned* MISC;
    gu32* ctl;
    int tid, lane, wave;
    int vcu, G;
    unsigned char* ws;
    typedef const float* cfptr_t;
    const __attribute__((address_space(4))) cfptr_t* in;
    float* out;
};
__device__ __forceinline__ float wave_sum(float v) {
#pragma unroll
    for (int o = 1; o < 64; o <<= 1) v += __shfl_xor(v, o);
    return v;
}
__device__ __forceinline__ float wave_max(float v) {
#pragma unroll
    for (int o = 1; o < 64; o <<= 1) v = fmaxf(v, __shfl_xor(v, o));
    return v;
}
__device__ __forceinline__ void transpose_item(const float* W, int K, int N, bf16* WT, int imode, LAS float* scr, int item, int lane) {
    const int nblk = N / 32, kb = item / nblk, nb = item % nblk, k0 = 64 * kb, n0 = 32 * nb;
    int drow = n0;
    if (imode != 0) { int j = n0, half = (imode == 2) ? 1 : 0; if (imode == 3) { const int hn = N / 2; if (n0 >= hn) { j = n0 - hn; half = 1; } } drow = (j / 128) * 256 + half * 128 + (j % 128); }
#pragma unroll 8
    for (int i = 0; i < 32; ++i) { const int kk = 2 * i + (lane >> 5); scr[kk * 33 + (lane & 31)] = W[(size_t)(k0 + kk) * N + n0 + (lane & 31)]; }
    LDS_WAIT(); asm volatile("" ::: "memory");
    const int c = lane & 7;
#pragma unroll
    for (int j = 0; j < 4; ++j) { const int n = (lane >> 3) + 8 * j; const LAS float* s = scr + (8 * c) * 33 + n;
        v4u o; o.x = pk2(s[0 * 33], s[1 * 33]); o.y = pk2(s[2 * 33], s[3 * 33]); o.z = pk2(s[4 * 33], s[5 * 33]); o.w = pk2(s[6 * 33], s[7 * 33]);
        *(GAS v4u*)(WT + (size_t)(drow + n) * K + k0 + 8 * c) = o; }
    LDS_WAIT(); asm volatile("" ::: "memory");
}
__device__ __forceinline__ void transpose_item8(const float* W, int K, int N, unsigned char* WT, int imode, float scale, LAS float* scr, int item, int lane) {
    const int nblk = N / 32, kb = item / nblk, nb = item % nblk, k0 = 64 * kb, n0 = 32 * nb;
    int drow = n0;
    if (imode != 0) { int j = n0, half = (imode == 2) ? 1 : 0; if (imode == 3) { const int hn = N / 2; if (n0 >= hn) { j = n0 - hn; half = 1; } } drow = (j / 128) * 256 + half * 128 + (j % 128); }
#pragma unroll 8
    for (int i = 0; i < 32; ++i) { const int kk = 2 * i + (lane >> 5); scr[kk * 33 + (lane & 31)] = __builtin_nontemporal_load(W + (size_t)(k0 + kk) * N + n0 + (lane & 31)); }
    LDS_WAIT(); asm volatile("" ::: "memory");
    const int c = lane & 7;
#pragma unroll
    for (int j = 0; j < 4; ++j) { const int n = (lane >> 3) + 8 * j; const LAS float* s = scr + (8 * c) * 33 + n;
        v2u o; o.x = pg8::pack4_f8(s[0 * 33] * scale, s[1 * 33] * scale, s[2 * 33] * scale, s[3 * 33] * scale); o.y = pg8::pack4_f8(s[4 * 33] * scale, s[5 * 33] * scale, s[6 * 33] * scale, s[7 * 33] * scale);
        *(GAS v2u*)(WT + (size_t)(drow + n) * K + k0 + 8 * c) = o; }
    LDS_WAIT(); asm volatile("" ::: "memory");
}
constexpr int XLD = 2 * D;
template <bool XBF> __device__ __forceinline__ f32x4 ld_x4(const void* xrow, int lane, int j) {
    if (XBF) { const v2u w = ((const GAS v2u*)xrow)[lane + 64 * j]; return (f32x4){bflo(w.x), bfhi(w.x), bflo(w.y), bfhi(w.y)}; }
    return ((const GAS f32x4*)xrow)[lane + 64 * j];
}
template <bool OUT8 = false, bool XBF = false> __device__ __forceinline__ void rms_row(const void* xrow, const float* g, bf16* orow, int lane, f32x4 (&hv)[4]) {
    const GAS f32x4* gr = (const GAS f32x4*)g + lane;
    f32x4 v[4]; float s = 0.f;
#pragma unroll
    for (int j = 0; j < 4; ++j) { v[j] = ld_x4<XBF>(xrow, lane, j); s += (v[j].x * v[j].x + v[j].y * v[j].y) + (v[j].z * v[j].z + v[j].w * v[j].w); }
    const float rstd = rsqrtf(wave_sum(s) * (1.f / D) + NORM_EPS);
    GAS unsigned long long* o8 = (GAS unsigned long long*)orow + lane; GAS unsigned* o4 = (GAS unsigned*)orow + lane;
#pragma unroll
    for (int j = 0; j < 4; ++j) { const f32x4 gg = gr[64 * j]; const f32x4 h = v[j] * rstd * gg; hv[j] = h;
        if (OUT8) o4[64 * j] = pg8::pack4_f8(h.x, h.y, h.z, h.w);
        else o8[64 * j] = (unsigned long long)pk2(h.x, h.y) | ((unsigned long long)pk2(h.z, h.w) << 32); }
}
__device__ __forceinline__ void rms_row_i8(f32x4 (&v)[4], const f32x4 (&gg)[4], unsigned char* orow, float* sa, int lane) {
    float s = 0.f;
#pragma unroll
    for (int j = 0; j < 4; ++j) s += (v[j].x * v[j].x + v[j].y * v[j].y) + (v[j].z * v[j].z + v[j].w * v[j].w);
    const float rstd = rsqrtf(wave_sum(s) * (1.f / D) + NORM_EPS); float am = 0.f;
#pragma unroll
    for (int j = 0; j < 4; ++j) { v[j] = v[j] * rstd * gg[j]; am = fmaxf(fmaxf(am, fmaxf(fabsf(v[j].x), fabsf(v[j].y))), fmaxf(fabsf(v[j].z), fabsf(v[j].w))); }
    am = fmaxf(wave_max(am), 1e-30f); const float inv = 127.f / am;
    GAS unsigned* o4 = (GAS unsigned*)orow + lane;
#pragma unroll
    for (int j = 0; j < 4; ++j) o4[64 * j] = pg8::pack4_i8(v[j].x * inv, v[j].y * inv, v[j].z * inv, v[j].w * inv);
    if (lane == 0) *sa = am * (1.f / 127.f);
}
template <bool XBF> __device__ __forceinline__ void norm_rows_i8(Frame& F, const void* x, const float* g, unsigned char* H8, float* SA) {
    const int gw = F.vcu * NWAVES + F.wave, NGW = F.G * NWAVES, lane = F.lane;
    f32x4 gg[4], cur[4], nxt[4];
#pragma unroll
    for (int j = 0; j < 4; ++j) { gg[j] = ((const GAS f32x4*)g)[lane + 64 * j]; cur[j] = (f32x4){0.f, 0.f, 0.f, 0.f}; nxt[j] = cur[j]; }
#define NR_ROW(m_) (XBF ? (const void*)((const bf16*)x + (size_t)(m_) * XLD) : (const void*)((const float*)x + (size_t)(m_) * D))
    if (gw < M) {
#pragma unroll
        for (int j = 0; j < 4; ++j) cur[j] = ld_x4<XBF>(NR_ROW(gw), lane, j); }
    for (int m = gw; m < M; m += NGW) {
        const int mn = m + NGW;
        if (mn < M) {
#pragma unroll
            for (int j = 0; j < 4; ++j) nxt[j] = ld_x4<XBF>(NR_ROW(mn), lane, j); }
        rms_row_i8(cur, gg, H8 + (size_t)m * D, SA + m, lane);
#pragma unroll
        for (int j = 0; j < 4; ++j) cur[j] = nxt[j];
    }
#undef NR_ROW
}
constexpr int WQ_NCOL = 2 * (INW + GATEW) + 2 * DFF;
__device__ __forceinline__ int wq_coff(int t) { return t == 4 ? 2 * (INW + GATEW) : (t >> 1) * (INW + GATEW) + (t & 1) * INW; }
__device__ __forceinline__ const float* wq_tensor(Frame& F, int t, int& N) {
    if (t == 4) { N = 2 * DFF; return F.in[13]; }
    const int L = t >> 1; if (t & 1) { N = GATEW; return F.in[7] + (size_t)L * D * GATEW; } N = INW; return F.in[2] + (size_t)L * D * INW;
}
__device__ __forceinline__ void wcolmax_partials(Frame& F, float* pcm) {
    const int gw = F.vcu * NWAVES + F.wave, NGW = F.G * NWAVES;
    constexpr int NB = WQ_NCOL / 256;
    for (int it = gw; it < NB * 8; it += NGW) {
        const int ke = it & 7, cbg = it >> 3;
        int t = 0, cb = cbg;
        { const int nb[5] = {INW / 256, GATEW / 256, INW / 256, GATEW / 256, 2 * DFF / 256};
#pragma unroll
          for (int i = 0; i < 4; ++i) if (t == i && cb >= nb[i]) { cb -= nb[i]; t = i + 1; } }
        int N; const float* W = wq_tensor(F, t, N);
        const GAS f32x4* p = (const GAS f32x4*)(W + (size_t)(128 * ke) * N + 256 * cb) + F.lane;
        f32x4 m = (f32x4){0.f, 0.f, 0.f, 0.f};
#pragma unroll 8
        for (int k = 0; k < 128; ++k) { const f32x4 v = p[(size_t)k * (N / 4)]; m.x = fmaxf(m.x, fabsf(v.x)); m.y = fmaxf(m.y, fabsf(v.y)); m.z = fmaxf(m.z, fabsf(v.z)); m.w = fmaxf(m.w, fabsf(v.w)); }
        *((GAS f32x4*)(pcm + (size_t)ke * WQ_NCOL + wq_coff(t) + 256 * cb) + F.lane) = m;
    }
}
__device__ __forceinline__ void transpose_item_i8(const float* W, int K, int N, unsigned char* WT, int imode, const float* pcm, float* swc, LAS float* scr, int item, int lane) {
    const int nblk = N / 32, kb = item / nblk, nb = item % nblk, k0 = 64 * kb, n0 = 32 * nb;
    int drow = n0;
    if (imode != 0) { int j = n0, half = (imode == 2) ? 1 : 0; if (imode == 3) { const int hn = N / 2; if (n0 >= hn) { j = n0 - hn; half = 1; } } drow = (j / 128) * 256 + half * 128 + (j % 128); }
    float cm = 1e-30f;
#pragma unroll
    for (int ke = 0; ke < 8; ++ke) cm = fmaxf(cm, pcm[(size_t)ke * WQ_NCOL + n0 + (lane & 31)]);
    const float cinv = 127.f / cm;
    if (kb == 0 && lane < 32) swc[n0 + lane] = cm * (1.f / 127.f);
#pragma unroll 8
    for (int i = 0; i < 32; ++i) { const int kk = 2 * i + (lane >> 5); scr[kk * 33 + (lane & 31)] = W[(size_t)(k0 + kk) * N + n0 + (lane & 31)]; }
    LDS_WAIT(); asm volatile("" ::: "memory");
    const int c = lane & 7;
#pragma unroll
    for (int j = 0; j < 4; ++j) { const int n = (lane >> 3) + 8 * j; const LAS float* s = scr + (8 * c) * 33 + n;
        const float scale = __shfl(cinv, n);
        v2u o; o.x = pg8::pack4_i8(s[0 * 33] * scale, s[1 * 33] * scale, s[2 * 33] * scale, s[3 * 33] * scale); o.y = pg8::pack4_i8(s[4 * 33] * scale, s[5 * 33] * scale, s[6 * 33] * scale, s[7 * 33] * scale);
        *(GAS v2u*)(WT + (size_t)(drow + n) * K + k0 + 8 * c) = o; }
    LDS_WAIT(); asm volatile("" ::: "memory");
}
template <bool OUT8 = false> __device__ __forceinline__ void norm_rows(Frame& F, const float* x, const float* g, bf16* H) {
    const int gw = F.vcu * NWAVES + F.wave, NGW = F.G * NWAVES;
    for (int m = gw; m < M; m += NGW) { f32x4 hv[4]; rms_row<OUT8>(x + (size_t)m * D, g, OUT8 ? (bf16*)((unsigned char*)H + (size_t)m * D) : H + (size_t)m * D, F.lane, hv); }
}
__device__ __forceinline__ void convert_small_weights(Frame& F) {
    LAS float* scr = (LAS float*)(F.lds + RING_OFF + F.wave * 16384); const float* PCM = (const float*)(F.ws + WS_PMAX); float* SWC = (float*)(F.ws + WS_SWC);
    const int gw = F.vcu * NWAVES + F.wave, NGW = F.G * NWAVES;
    constexpr int I_IN = (D / 64) * (INW / 32), I_G = (D / 64) * (GATEW / 32), I_B = (512 / 64) * (D / 32), I_O = (D / 64) * (D / 32), I_L = I_IN + I_G + 2 * I_B + I_O;
    constexpr int I_GU = (D / 64) * (2 * DFF / 32), I_DN = (DFF / 64) * (D / 32), NITEMS = 2 * I_L + I_GU + I_DN;
    for (int it = gw; it < NITEMS; it += NGW) {
        int r = it;
        if (r < 2 * I_L) { const int L = r / I_L; r -= L * I_L; bf16* wt = (bf16*)(F.ws + WS_WT + (size_t)L * WT_LAYER);
            if (r < I_IN) { transpose_item_i8(F.in[2] + (size_t)L * D * INW, D, INW, (unsigned char*)wt + WT_WIN, 0, PCM + wq_coff(2 * L), SWC + wq_coff(2 * L), scr, r, F.lane); continue; } r -= I_IN;
            if (r < I_G) { transpose_item_i8(F.in[7] + (size_t)L * D * GATEW, D, GATEW, (unsigned char*)wt + WT_WG, 0, PCM + wq_coff(2 * L + 1), SWC + wq_coff(2 * L + 1), scr, r, F.lane); continue; } r -= I_G;
            if (r < I_B) { transpose_item(F.in[9] + (size_t)L * 512 * D, 512, D, (bf16*)((unsigned char*)wt + WT_WSB), 0, scr, r, F.lane); continue; } r -= I_B;
            if (r < I_B) { transpose_item(F.in[10] + (size_t)L * 512 * D, 512, D, (bf16*)((unsigned char*)wt + WT_WDF), 0, scr, r, F.lane); continue; } r -= I_B;
            transpose_item(F.in[11] + (size_t)L * D * D, D, D, (bf16*)((unsigned char*)wt + WT_WOUT), 0, scr, r, F.lane); continue; }
        r -= 2 * I_L;
        if (r < I_GU) { transpose_item_i8(F.in[13], D, 2 * DFF, F.ws + WS_WGU, 3, PCM + wq_coff(4), SWC + wq_coff(4), scr, r, F.lane); continue; } r -= I_GU;
        transpose_item(F.in[14], DFF, D, (bf16*)(F.ws + WS_WDOWN), 0, scr, r, F.lane);
    }
}
constexpr int CV_ITEMS = 56, CV_UNITS = NEXP * (2 * (D / 64) * (DFE / 32) + (DFE / 64) * (D / 32)) / CV_ITEMS;
static_assert(CV_UNITS * CV_ITEMS == NEXP * (2 * (D / 64) * (DFE / 32) + (DFE / 64) * (D / 32)) && CV_ITEMS % NWAVES == 0, "conversion units");
struct CvItem { const float* src; unsigned char* dst; int N, K; float scale; int bf; };
constexpr int CVB_SB = (512 / 64) * (D / 32), CVB_O = (D / 64) * (D / 32), CVB_L = 2 * CVB_SB + CVB_O, CVB_DN = (DFF / 64) * (D / 32), CVB_ITEMS = 2 * CVB_L + CVB_DN;
__device__ __forceinline__ CvItem cv_decode_bf16(const Frame& F, int it) {
    CvItem c; c.scale = 1.f; c.bf = 1; c.N = D; const float* W; unsigned char* WT; int r = it;
    if (r < 2 * CVB_L) { const int L = r / CVB_L; r -= L * CVB_L; unsigned char* wt = F.ws + WS_WT + (size_t)L * WT_LAYER;
        if (r < CVB_SB) { W = F.in[9] + (size_t)L * 512 * D; c.K = 512; WT = wt + WT_WSB; }
        else if (r < 2 * CVB_SB) { r -= CVB_SB; W = F.in[10] + (size_t)L * 512 * D; c.K = 512; WT = wt + WT_WDF; }
        else { r -= 2 * CVB_SB; W = F.in[11] + (size_t)L * D * D; c.K = D; WT = wt + WT_WOUT; } }
    else { r -= 2 * CVB_L; W = F.in[14]; c.K = DFF; WT = F.ws + WS_WDOWN; c.bf = 0; c.scale = SC_W2; }
    const int nblk = D / 32, kb = r / nblk, nb = r - kb * nblk, k0 = 64 * kb, n0 = 32 * nb;
    c.src = W + (size_t)k0 * D + n0; c.dst = WT + ((size_t)n0 * c.K + k0) * (c.bf ? 2 : 1); return c;
}
__device__ __forceinline__ CvItem cv_decode(const Frame& F, int it) {
    constexpr int I_1 = (D / 64) * (DFE / 32), I_2 = (DFE / 64) * (D / 32), I_E = 2 * I_1 + I_2;
    const int e = it / I_E; int r = it - e * I_E; CvItem c; c.bf = 0;
    const float* W; unsigned char* WT; int imode;
    if (r < I_1) { W = F.in[16] + (size_t)e * D * DFE; c.K = D; c.N = DFE; WT = F.ws + WS_MOE13 + (size_t)e * MOE13_EXP; imode = 1; c.scale = SC_W13; }
    else if (r < 2 * I_1) { r -= I_1; W = F.in[17] + (size_t)e * D * DFE; c.K = D; c.N = DFE; WT = F.ws + WS_MOE13 + (size_t)e * MOE13_EXP; imode = 2; c.scale = SC_W13; }
    else { r -= 2 * I_1; W = F.in[18] + (size_t)e * DFE * D; c.K = DFE; c.N = D; WT = F.ws + WS_MOE2 + (size_t)e * MOE2_EXP; imode = 0; c.scale = SC_W2; }
    const int nblk = c.N / 32, kb = r / nblk, nb = r - kb * nblk, k0 = 64 * kb, n0 = 32 * nb;
    const int drow = (imode == 0) ? n0 : (n0 / 128) * 256 + (imode - 1) * 128 + (n0 % 128);
    c.src = W + (size_t)k0 * c.N + n0; c.dst = WT + (size_t)drow * c.K + k0; return c;
}
__device__ __forceinline__ void cv_load(const CvItem& c, int lane, f32x4 (&v)[8]) {
    const float* p = c.src + (size_t)(lane >> 3) * c.N + 4 * (lane & 7);
#pragma unroll
    for (int j = 0; j < 8; ++j) v[j] = __builtin_nontemporal_load((const f32x4*)(p + (size_t)(8 * j) * c.N));
}
__device__ __forceinline__ void cv_store(const CvItem& c, int lane, const f32x4 (&v)[8], LAS float* scr) {
#pragma unroll
    for (int j = 0; j < 8; ++j) { LAS float* d = scr + (8 * j + (lane >> 3)) * 33 + 4 * (lane & 7); d[0] = v[j].x; d[1] = v[j].y; d[2] = v[j].z; d[3] = v[j].w; }
    LDS_WAIT(); asm volatile("" ::: "memory");
    const int cc = lane & 7; const float scale = c.scale;
    if (c.bf) {
#pragma unroll
        for (int j = 0; j < 4; ++j) { const int n = (lane >> 3) + 8 * j; const LAS float* s = scr + (8 * cc) * 33 + n;
            v4u o; o.x = pk2(s[0 * 33], s[1 * 33]); o.y = pk2(s[2 * 33], s[3 * 33]); o.z = pk2(s[4 * 33], s[5 * 33]); o.w = pk2(s[6 * 33], s[7 * 33]);
            *(GAS v4u*)(c.dst + ((size_t)n * c.K + 8 * cc) * 2) = o; }
    } else {
#pragma unroll
        for (int j = 0; j < 4; ++j) { const int n = (lane >> 3) + 8 * j; const LAS float* s = scr + (8 * cc) * 33 + n;
            v2u o; o.x = pg8::pack4_f8(s[0 * 33] * scale, s[1 * 33] * scale, s[2 * 33] * scale, s[3 * 33] * scale); o.y = pg8::pack4_f8(s[4 * 33] * scale, s[5 * 33] * scale, s[6 * 33] * scale, s[7 * 33] * scale);
            *(GAS v2u*)(c.dst + (size_t)n * c.K + 8 * cc) = o; }
    }
    LDS_WAIT(); asm volatile("" ::: "memory");
}
template <bool BF> __device__ __forceinline__ void convert_item_unit(Frame& F, int unit) {
    LAS float* scr = (LAS float*)(F.lds + RING_OFF + F.wave * 9216);
    const int it0 = unit * CV_ITEMS + F.wave * (CV_ITEMS / NWAVES);
    constexpr int NIT = CV_ITEMS / NWAVES, LIM = BF ? CVB_ITEMS : 0x7fffffff;
    f32x4 va[8], vb[8];
    CvItem ca, cb;
    if (it0 < LIM) { ca = BF ? cv_decode_bf16(F, it0) : cv_decode(F, it0); cv_load(ca, F.lane, va); }
#pragma unroll
    for (int i = 0; i < NIT; i += 2) {
        if (i + 1 < NIT && it0 + i + 1 < LIM) { cb = BF ? cv_decode_bf16(F, it0 + i + 1) : cv_decode(F, it0 + i + 1); cv_load(cb, F.lane, vb); }
        if (it0 + i < LIM) cv_store(ca, F.lane, va, scr);
        if (i + 1 < NIT) {
            if (i + 2 < NIT && it0 + i + 2 < LIM) { ca = BF ? cv_decode_bf16(F, it0 + i + 2) : cv_decode(F, it0 + i + 2); cv_load(ca, F.lane, va); }
            if (it0 + i + 1 < LIM) cv_store(cb, F.lane, vb, scr);
        }
    }
}
__device__ __forceinline__ void convert_i8_colblock(Frame& F, const float* W, int N, unsigned char* WT, int imode, float* swc, int nb) {
    const int lane = F.lane, w = F.wave, n0 = 32 * nb;
    int drow = n0;
    if (imode == 3) { const int hn = N / 2; int j = n0, half = 0; if (n0 >= hn) { j = n0 - hn; half = 1; } drow = (j / 128) * 256 + half * 128 + (j % 128); }
    LAS float* scr = (LAS float*)(F.lds + RING_OFF + w * 9216); LAS float* CMX = (LAS float*)(F.lds + RING_OFF + NWAVES * 9216);
    const float* p = W + (size_t)(128 * w + (lane >> 3)) * N + n0 + 4 * (lane & 7);
    f32x4 v[16]; f32x4 m = (f32x4){0.f, 0.f, 0.f, 0.f};
#pragma unroll
    for (int j = 0; j < 16; ++j) v[j] = __builtin_nontemporal_load((const f32x4*)(p + (size_t)(8 * j) * N));
#pragma unroll
    for (int j = 0; j < 16; ++j) { m.x = fmaxf(m.x, fabsf(v[j].x)); m.y = fmaxf(m.y, fabsf(v[j].y)); m.z = fmaxf(m.z, fabsf(v[j].z)); m.w = fmaxf(m.w, fabsf(v[j].w)); }
#pragma unroll
    for (int o = 8; o < 64; o <<= 1) { m.x = fmaxf(m.x, __shfl_xor(m.x, o)); m.y = fmaxf(m.y, __shfl_xor(m.y, o)); m.z = fmaxf(m.z, __shfl_xor(m.z, o)); m.w = fmaxf(m.w, __shfl_xor(m.w, o)); }
    if (lane < 8) { LAS float* d = CMX + w * 32 + 4 * lane; d[0] = m.x; d[1] = m.y; d[2] = m.z; d[3] = m.w; }
    __syncthreads();
    float cm = 1e-30f;
#pragma unroll
    for (int ke = 0; ke < NWAVES; ++ke) cm = fmaxf(cm, CMX[ke * 32 + (lane & 31)]);
    const float cinv = 127.f / cm;
    if (w == 0 && lane < 32) swc[n0 + lane] = cm * (1.f / 127.f);
    const int c = lane & 7;
#pragma unroll
    for (int hf = 0; hf < 2; ++hf) {
#pragma unroll
        for (int j = 0; j < 8; ++j) { LAS float* d = scr + (8 * j + (lane >> 3)) * 33 + 4 * c; const f32x4 x = v[8 * hf + j]; d[0] = x.x; d[1] = x.y; d[2] = x.z; d[3] = x.w; }
        LDS_WAIT(); asm volatile("" ::: "memory");
        const int k0 = 128 * w + 64 * hf;
#pragma unroll
        for (int j = 0; j < 4; ++j) { const int n = (lane >> 3) + 8 * j; const LAS float* s = scr + (8 * c) * 33 + n;
            const float scale = __shfl(cinv, n);
            v2u o; o.x = pg8::pack4_i8(s[0 * 33] * scale, s[1 * 33] * scale, s[2 * 33] * scale, s[3 * 33] * scale); o.y = pg8::pack4_i8(s[4 * 33] * scale, s[5 * 33] * scale, s[6 * 33] * scale, s[7 * 33] * scale);
            *(GAS v2u*)(WT + (size_t)(drow + n) * D + k0 + 8 * c) = o; }
        LDS_WAIT(); asm volatile("" ::: "memory");
    }
    __syncthreads();
}
constexpr int CVQ_I8 = GATEW / 32 + INW / 32 + GATEW / 32 + 2 * DFF / 32, CVQ_BF = (CVB_ITEMS + CV_ITEMS - 1) / CV_ITEMS, CVQ_ALL = CVQ_I8 + CVQ_BF + CV_UNITS;
__device__ __forceinline__ void convert_queue_unit(Frame& F, int cv) {
    float* SWC = (float*)(F.ws + WS_SWC);
    if (cv < CVQ_I8) {
        int q = cv;
        if (q < GATEW / 32) { convert_i8_colblock(F, F.in[7], GATEW, F.ws + WS_WT + WT_WG, 0, SWC + wq_coff(1), q); return; } q -= GATEW / 32;
        if (q < INW / 32) { convert_i8_colblock(F, F.in[2] + (size_t)D * INW, INW, F.ws + WS_WT + WT_LAYER + WT_WIN, 0, SWC + wq_coff(2), q); return; } q -= INW / 32;
        if (q < GATEW / 32) { convert_i8_colblock(F, F.in[7] + (size_t)D * GATEW, GATEW, F.ws + WS_WT + WT_LAYER + WT_WG, 0, SWC + wq_coff(3), q); return; } q -= GATEW / 32;
        convert_i8_colblock(F, F.in[13], 2 * DFF, F.ws + WS_WGU, 3, SWC + wq_coff(4), q); return;
    }
    cv -= CVQ_I8;
    if (cv < CVQ_BF) { convert_item_unit<true>(F, cv); return; }
    convert_item_unit<false>(F, cv - CVQ_BF);
}
__device__ __forceinline__ void norm_route_rows(Frame& F, const bf16* x, const float* g, bf16* H, const float* wr, int* ltok, float* lw, int* tpos) {
    LAS float* WRT = (LAS float*)(F.lds + RING_OFF);
    LAS unsigned* LCNT = (LAS unsigned*)(F.lds + RING_OFF + 32768);
    LAS unsigned* LBASE = LCNT + 8;
    LAS unsigned* REC_E = (LAS unsigned*)(F.lds + RING_OFF + 33024);
    const int RPW = (M + F.G - 1) / F.G;
    LAS unsigned* REC_P0 = REC_E + 1024; LAS unsigned* REC_P1 = REC_P0 + 1024; LAS float* REC_W = (LAS float*)(REC_P1 + 1024);
    for (int i = F.tid; i < 8192; i += NWAVES * 64) WRT[(i & 7) * 1024 + (i >> 3)] = wr[i];
    if (F.tid < 16) LCNT[F.tid] = 0u;
    __syncthreads();
    const int row0 = (int)blockIdx.x * RPW;
    for (int r = F.wave; r < RPW; r += NWAVES) {
        const int m = row0 + r; if (m >= M) break;
        f32x4 hv[4]; rms_row<true, true>(x + (size_t)m * XLD, g, (bf16*)((unsigned char*)H + (size_t)m * D), F.lane, hv);
        float lg[8];
#pragma unroll
        for (int e = 0; e < 8; ++e) { float s = 0.f;
#pragma unroll
            for (int j = 0; j < 4; ++j) { const f32x4 w = *(const LAS f32x4*)(WRT + e * 1024 + 256 * j + 4 * F.lane); s += (hv[j].x * w.x + hv[j].y * w.y) + (hv[j].z * w.z + hv[j].w * w.w); }
            lg[e] = wave_sum(s); }
        int e0 = 0; float b0 = lg[0];
#pragma unroll
        for (int e = 1; e < 8; ++e) if (lg[e] > b0) { b0 = lg[e]; e0 = e; }
        int e1 = -1; float b1 = -INFINITY;
#pragma unroll
        for (int e = 0; e < 8; ++e) if (e != e0 && lg[e] > b1) { b1 = lg[e]; e1 = e; }
        if (F.lane == 0) {
            const float w0 = 1.f / (1.f + __expf(b1 - b0));
            REC_E[r] = (unsigned)e0 | ((unsigned)e1 << 8); REC_W[r] = w0;
            REC_P0[r] = atomicAdd((unsigned*)&LCNT[e0], 1u); REC_P1[r] = atomicAdd((unsigned*)&LCNT[e1], 1u);
        }
    }
    __syncthreads();
    if (F.tid < 8) LBASE[F.tid] = __hip_atomic_fetch_add((unsigned*)(F.ctl + CW_CNT + 64 * F.tid), LCNT[F.tid], RLX_AGENT);
    __syncthreads();
    for (int r = F.tid; r < RPW; r += NWAVES * 64) {
        const int m = row0 + r; if (m >= M) break;
        const unsigned ee = REC_E[r]; const int e0 = ee & 0xff, e1 = ee >> 8; const float w0 = REC_W[r];
        const unsigned p0 = LBASE[e0] + REC_P0[r], p1 = LBASE[e1] + REC_P1[r];
        ltok[(size_t)e0 * M + p0] = m; lw[(size_t)e0 * M + p0] = w0;
        ltok[(size_t)e1 * M + p1] = m; lw[(size_t)e1 * M + p1] = 1.f - w0;
        tpos[2 * m] = (e0 << 16) | (int)p0; tpos[2 * m + 1] = (e1 << 16) | (int)p1;
    }
    __syncthreads();
}
__device__ __forceinline__ void moe_plan(Frame& F) {
    LAS int* PLAN = (LAS int*)(F.lds + PLAN_OFF);
    __syncthreads();
    if (cur_tid() == 0) { int acc = 0;
        for (int e = 0; e < 8; ++e) { const int c = (int)__hip_atomic_load((unsigned*)(F.ctl + CW_CNT + 64 * e), RLX_AGENT); PLAN[e] = acc; PLAN[9 + e] = c; acc += (c + 255) >> 8; }
        PLAN[8] = acc; PLAN[17] = acc; }
    __syncthreads();
}
__device__ __forceinline__ void moe_gather(Frame& F, const bf16* H, bf16* XS, const int* ltok, const float* lw, float* sw) {
    const LAS int* PLAN = (const LAS int*)(F.lds + PLAN_OFF);
    const int gw = F.vcu * NWAVES + F.wave, NGW = F.G * NWAVES, nslot = PLAN[17] * 256;
    for (int sg = gw; sg < nslot; sg += NGW) {
        const int tile = sg >> 8; int e = 0;
#pragma unroll
        for (int j = 1; j < 8; ++j) e += (tile >= PLAN[j]) ? 1 : 0;
        const int idx = (tile - PLAN[e]) * 256 + (sg & 255); const bool valid = idx < PLAN[9 + e];
        int tok = 0; float w = 0.f;
        if (valid) { tok = ltok[(size_t)e * M + idx]; w = lw[(size_t)e * M + idx]; }
        const GAS v4u* src = (const GAS v4u*)((const unsigned char*)H + (size_t)tok * D) + F.lane; GAS v4u* dst = (GAS v4u*)((unsigned char*)XS + (size_t)sg * D) + F.lane;
        dst[0] = src[0];
        if (F.lane == 0) sw[sg] = w;
    }
}


__device__ __forceinline__ void moe_combine(Frame& F, float* out, const bf16* YS, const int* tpos) {
    const LAS int* PLAN = (const LAS int*)(F.lds + PLAN_OFF);
    const int gw = F.vcu * NWAVES + F.wave, NGW = F.G * NWAVES;
    for (int m = gw; m < M; m += NGW) {
        const int t0 = tpos[2 * m], t1 = tpos[2 * m + 1];
        const size_t s0 = (size_t)(PLAN[t0 >> 16] * 256 + (t0 & 0xffff)), s1 = (size_t)(PLAN[t1 >> 16] * 256 + (t1 & 0xffff));
        v4u xa[2], ya[2], yb[2];
#pragma unroll
        for (int j = 0; j < 2; ++j) { const int c = 512 * j + 8 * F.lane;
            xa[j] = *(const GAS v4u*)((const bf16*)out + (size_t)m * XLD + c); ya[j] = *(const GAS v4u*)(YS + s0 * D + c); yb[j] = *(const GAS v4u*)(YS + s1 * D + c); }
        asm volatile("s_waitcnt vmcnt(0)" ::: "memory");
#pragma unroll
        for (int j = 0; j < 2; ++j) { const int c = 512 * j + 8 * F.lane; const v4u x = xa[j], a = ya[j], b = yb[j];
            GAS f32x4* op = (GAS f32x4*)(out + (size_t)m * D + c); f32x4 o0, o1;
            o0.x = bflo(x.x) + (bflo(a.x) + bflo(b.x)); o0.y = bfhi(x.x) + (bfhi(a.x) + bfhi(b.x)); o0.z = bflo(x.y) + (bflo(a.y) + bflo(b.y)); o0.w = bfhi(x.y) + (bfhi(a.y) + bfhi(b.y));
            o1.x = bflo(x.z) + (bflo(a.z) + bflo(b.z)); o1.y = bfhi(x.z) + (bfhi(a.z) + bfhi(b.z)); o1.z = bflo(x.w) + (bflo(a.w) + bflo(b.w)); o1.w = bfhi(x.w) + (bfhi(a.w) + bfhi(b.w));
            op[0] = o0; op[1] = o1; }
    }
}

typedef short bf16x8 __attribute__((ext_vector_type(8)));
typedef float f32x16 __attribute__((ext_vector_type(16)));
constexpr size_t FR_SBK = 0, FR_SBV = 32 * MiB, FR_DFK = 64 * MiB, FR_DFV = 96 * MiB;
constexpr float LOG2E = 1.4426950408889634f;
constexpr int NKB = SEQ / 32;
#define MFMA32(a, b, c) __builtin_amdgcn_mfma_f32_32x32x16_bf16((a), (b), (c), 0, 0, 0)
__device__ __forceinline__ unsigned cvtpk(float lo, float hi) { return pg8::cvt_pk_bf16(lo, hi); }
__device__ __forceinline__ bf16x8 as_bf16x8(v4u v) { return __builtin_bit_cast(bf16x8, v); }

struct EpiQkStore {
    static constexpr bool STAGE = false; static constexpr bool PERM = true, PERMV = false, AFTER_DRAIN = false;
    bf16* O; int ldc; const float* sa; const float* swc; unsigned char* fragk; const float* gk; LAS float* xch; unsigned char* fragsk;
    __device__ __forceinline__ void operator()(const pg8::f32x4 (&acc)[2][2][4][2], const pg8::Unit& u, int wr, int wc, int fr, int fq) const {
        const int row0 = u.pm * 256 + wr * 64 + fr, col0 = u.pn * 256 + wc * 32 + 8 * fq;
        pg8::f32x4 cs[2][2]; float rsv[2][4];
#pragma unroll
        for (int bj = 0; bj < 2; ++bj)
#pragma unroll
            for (int n = 0; n < 2; ++n) cs[bj][n] = *(const pg8::f32x4*)(swc + col0 + bj * 128 + 4 * n);
#pragma unroll
        for (int ai = 0; ai < 2; ++ai)
#pragma unroll
            for (int m = 0; m < 4; ++m) rsv[ai][m] = sa[row0 + ai * 128 + m * 16];
        if (u.pn == 2 || u.pn == 3) {
#pragma unroll
            for (int ai = 0; ai < 2; ++ai)
#pragma unroll
                for (int m = 0; m < 4; ++m) { const int r = u.pm * 256 + ai * 128 + wr * 64 + m * 16 + fr; const float rs = rsv[ai][m];
                    const int b = r >> 13, kb = (r & (SEQ - 1)) >> 5, key = r & 31;
#pragma unroll
                    for (int bj = 0; bj < 2; ++bj) { const pg8::f32x4 v0 = pg8::acc_i2f(acc[ai][bj][m][0], rs) * cs[bj][0], v1 = pg8::acc_i2f(acc[ai][bj][m][1], rs) * cs[bj][1];
                        pg8::u32x4 w; w.x = pg8::cvt_pk_bf16(v0[0], v0[1]); w.y = pg8::cvt_pk_bf16(v0[2], v0[3]); w.z = pg8::cvt_pk_bf16(v1[0], v1[1]); w.w = pg8::cvt_pk_bf16(v1[2], v1[3]);
                        const int hm = 4 * (u.pn - 2) + 2 * bj + (wc >> 1), kk = 2 * (wc & 1) + (fq >> 1);
                        *(pg8::u32x4*)(fragsk + ((size_t)((b * 8 + hm) * NKB + kb) * 4 + kk) * 1024 + (size_t)(key + 32 * (fq & 1)) * 16) = w; } }
            return;
        }
        if (u.pn < 8) {
#pragma unroll
            for (int ai = 0; ai < 2; ++ai)
#pragma unroll
                for (int m = 0; m < 4; ++m) { const int row = row0 + ai * 128 + m * 16; bf16* rowp = O + (size_t)row * ldc + col0; const float rs = rsv[ai][m];
#pragma unroll
                    for (int bj = 0; bj < 2; ++bj) { const pg8::f32x4 v0 = pg8::acc_i2f(acc[ai][bj][m][0], rs) * cs[bj][0], v1 = pg8::acc_i2f(acc[ai][bj][m][1], rs) * cs[bj][1];
                        pg8::u32x4 w; w.x = pg8::cvt_pk_bf16(v0[0], v0[1]); w.y = pg8::cvt_pk_bf16(v0[2], v0[3]); w.z = pg8::cvt_pk_bf16(v1[0], v1[1]); w.w = pg8::cvt_pk_bf16(v1[2], v1[3]);
                        *(pg8::u32x4*)(rowp + bj * 128) = w; } }
            return;
        }
        asm volatile("" : "+v"(fr), "+v"(fq));
        int xb = (wr * 64 + fr) * 8 + wc; asm volatile("" : "+v"(xb));
        LAS float* const xw = xch + xb; LAS float* const xp = xch + (xb ^ 1);
        const int dim0 = 32 * (wc & 1) + 8 * fq;
#pragma unroll
        for (int ai = 0; ai < 2; ++ai)
#pragma unroll
            for (int m = 0; m < 4; ++m) { const int rl = ai * 128 + wr * 64 + m * 16 + fr; const float rs = rsv[ai][m]; (void)rl;
#pragma unroll
                for (int bj = 0; bj < 2; ++bj) { const pg8::f32x4 v0 = pg8::acc_i2f(acc[ai][bj][m][0], rs) * cs[bj][0], v1 = pg8::acc_i2f(acc[ai][bj][m][1], rs) * cs[bj][1];
                    float ss = ((v0[0] * v0[0] + v0[1] * v0[1]) + (v0[2] * v0[2] + v0[3] * v0[3])) + ((v1[0] * v1[0] + v1[1] * v1[1]) + (v1[2] * v1[2] + v1[3] * v1[3]));
                    ss += __shfl_xor(ss, 16); ss += __shfl_xor(ss, 32);
                    if (fq == 0) xw[(ai * 128 + m * 16) * 8 + bj * 4] = ss; } }
        asm volatile("s_waitcnt lgkmcnt(0)\n\ts_barrier" ::: "memory");
        const pg8::f32x4 g0 = *(const pg8::f32x4*)(gk + dim0), g1 = *(const pg8::f32x4*)(gk + dim0 + 4);
#pragma unroll
        for (int ai = 0; ai < 2; ++ai)
#pragma unroll
            for (int m = 0; m < 4; ++m) { const int rl = ai * 128 + wr * 64 + m * 16 + fr, r = u.pm * 256 + rl; const float rs = rsv[ai][m];
                const int b = r >> 13, kb = (r & (SEQ - 1)) >> 5, key = r & 31;
#pragma unroll
                for (int bj = 0; bj < 2; ++bj) { const float ss = xw[(ai * 128 + m * 16) * 8 + bj * 4] + xp[(ai * 128 + m * 16) * 8 + bj * 4];
                    const float rstd = rsqrtf(ss * (1.f / 64.f) + NORM_EPS);
                    const pg8::f32x4 v0 = pg8::acc_i2f_again(acc[ai][bj][m][0], rs) * cs[bj][0] * rstd * g0, v1 = pg8::acc_i2f_again(acc[ai][bj][m][1], rs) * cs[bj][1] * rstd * g1;
                    pg8::u32x4 w; w.x = pg8::cvt_pk_bf16(v0[0], v0[1]); w.y = pg8::cvt_pk_bf16(v0[2], v0[3]); w.z = pg8::cvt_pk_bf16(v1[0], v1[1]); w.w = pg8::cvt_pk_bf16(v1[2], v1[3]);
                    const int hm = 4 * (u.pn - 8) + 2 * bj + (wc >> 1), kk = 2 * (wc & 1) + (fq >> 1);
                    *(pg8::u32x4*)(fragk + ((size_t)((b * 8 + hm) * NKB + kb) * 4 + kk) * 1024 + (size_t)(key + 32 * (fq & 1)) * 16) = w; } }
    }
};
struct EpiVtFrag {
    static constexpr bool STAGE = false; static constexpr bool PERM = false, PERMV = true, AFTER_DRAIN = false;
    unsigned char* frag; const float* sa; const float* swc_sb; const float* swc_df;
    __device__ __forceinline__ void operator()(const pg8::f32x4 (&acc)[2][2][4][2], const pg8::Unit& u, int wr, int wc, int fr, int fq) const {
        const int hq = fq & 1, s = fq >> 1;
        pg8::f32x4 cs[2][2]; float rsv[2][4]; size_t goff[2];
#pragma unroll
        for (int bj = 0; bj < 2; ++bj) { const int T = u.pn * 256 + bj * 128 + wc * 32;
#pragma unroll
            for (int n = 0; n < 2; ++n) cs[bj][n] = *(const pg8::f32x4*)(sa + T + 16 * s + 8 * n + 4 * hq);
            goff[bj] = (size_t)((T >> 13) * NKB + ((T & (SEQ - 1)) >> 5)); }
#pragma unroll
        for (int ai = 0; ai < 2; ++ai)
#pragma unroll
            for (int m = 0; m < 4; ++m) { const int r = u.pm * 256 + ai * 128 + wr * 64 + m * 16 + fr; rsv[ai][m] = (r < 512) ? swc_sb[r] : swc_df[r - 512]; }
#pragma unroll
        for (int ai = 0; ai < 2; ++ai)
#pragma unroll
            for (int m = 0; m < 4; ++m) { const int r = u.pm * 256 + ai * 128 + wr * 64 + m * 16 + fr; const float rs = rsv[ai][m];
#pragma unroll
                for (int bj = 0; bj < 2; ++bj) { const int b = (int)(goff[bj] >> 8), kb = (int)(goff[bj] & (NKB - 1));
                    size_t fo;
                    if (r < 512) fo = FR_SBV / 1024 + ((size_t)((b * 8 + (r >> 6)) * NKB + kb) * 4 + ((r >> 5) & 1) * 2 + s);
                    else { const int r2 = r - 512; fo = FR_DFV / 1024 + ((size_t)((b * 4 + (r2 >> 7)) * NKB + kb) * 8 + ((r2 >> 5) & 3) * 2 + s); }
                    const pg8::f32x4 v0 = pg8::acc_i2f(acc[ai][bj][m][0], rs) * cs[bj][0], v1 = pg8::acc_i2f(acc[ai][bj][m][1], rs) * cs[bj][1];
                    pg8::u32x4 w; w.x = pg8::cvt_pk_bf16(v0[0], v0[1]); w.y = pg8::cvt_pk_bf16(v0[2], v0[3]); w.z = pg8::cvt_pk_bf16(v1[0], v1[1]); w.w = pg8::cvt_pk_bf16(v1[2], v1[3]);
                    *(pg8::u32x4*)(frag + fo * 1024 + (size_t)((r & 31) + 32 * hq) * 16) = w; } }
    }
};
__device__ __forceinline__ void repack_kv(Frame& F, const bf16* proj, unsigned char* frag, const float* gk) {
    const int gw = F.vcu * NWAVES + F.wave, NGW = F.G * NWAVES, lane = F.lane, m = lane & 31, h = lane >> 5;
    for (int it = gw; it < BATCH * NKB * 8; it += NGW) {
        const int bk = it >> 3, item = 8 + (it & 7), b = bk >> 8, kb = bk & (NKB - 1);
        if (item < 16) {
            const bool df = item >= 8; const int hh = item & 7;
            const bf16* src = proj + (size_t)(b * SEQ + 32 * kb + m) * INW + (df ? C_DFK : C_SBK) + 64 * hh + 8 * h;
            v4u v[4];
#pragma unroll
            for (int kk = 0; kk < 4; ++kk) v[kk] = *(const GAS v4u*)(src + 16 * kk);
            if (df) {
                float x[32]; float ss = 0.f;
#pragma unroll
                for (int kk = 0; kk < 4; ++kk) { x[8 * kk + 0] = bflo(v[kk].x); x[8 * kk + 1] = bfhi(v[kk].x); x[8 * kk + 2] = bflo(v[kk].y); x[8 * kk + 3] = bfhi(v[kk].y);
                    x[8 * kk + 4] = bflo(v[kk].z); x[8 * kk + 5] = bfhi(v[kk].z); x[8 * kk + 6] = bflo(v[kk].w); x[8 * kk + 7] = bfhi(v[kk].w); }
#pragma unroll
                for (int i = 0; i < 32; ++i) ss += x[i] * x[i];
                ss += __shfl_xor(ss, 32);
                const float rstd = rsqrtf(ss * (1.f / 64.f) + NORM_EPS);
#pragma unroll
                for (int kk = 0; kk < 4; ++kk) { const f32x4 g0 = *(const GAS f32x4*)(gk + 16 * kk + 8 * h), g1 = *(const GAS f32x4*)(gk + 16 * kk + 8 * h + 4);
                    v[kk].x = pk2(x[8 * kk + 0] * rstd * g0.x, x[8 * kk + 1] * rstd * g0.y); v[kk].y = pk2(x[8 * kk + 2] * rstd * g0.z, x[8 * kk + 3] * rstd * g0.w);
                    v[kk].z = pk2(x[8 * kk + 4] * rstd * g1.x, x[8 * kk + 5] * rstd * g1.y); v[kk].w = pk2(x[8 * kk + 6] * rstd * g1.z, x[8 * kk + 7] * rstd * g1.w); }
            }
            GAS v4u* dst = (GAS v4u*)(frag + (df ? FR_DFK : FR_SBK) + ((size_t)((b * 8 + hh) * NKB + kb) * 4) * 1024) + lane;
#pragma unroll
            for (int kk = 0; kk < 4; ++kk) dst[kk * 64] = v[kk];
        } else {
            const bool df = item >= 24; const int hh = item & 7;
            const int colbase = df ? (C_DFV + 128 * (hh >> 1) + 64 * (hh & 1)) : (C_SBV + 64 * hh);
            const bf16* src = proj + (size_t)(b * SEQ + 32 * kb) * INW + colbase + m;
            GAS v4u* dst = df ? (GAS v4u*)(frag + FR_DFV + ((size_t)((b * 4 + (hh >> 1)) * NKB + kb) * 8 + 4 * (hh & 1)) * 1024) + lane
                              : (GAS v4u*)(frag + FR_SBV + ((size_t)((b * 8 + hh) * NKB + kb) * 4) * 1024) + lane;
#pragma unroll
            for (int db = 0; db < 2; ++db)
#pragma unroll
                for (int s = 0; s < 2; ++s) { unsigned e[8];
#pragma unroll
                    for (int j = 0; j < 8; ++j) e[j] = src[(size_t)(16 * s + 8 * (j >> 2) + 4 * h + (j & 3)) * INW + 32 * db];
                    v4u o; o.x = e[0] | (e[1] << 16); o.y = e[2] | (e[3] << 16); o.z = e[4] | (e[5] << 16); o.w = e[6] | (e[7] << 16);
                    dst[(db * 2 + s) * 64] = o; }
        }
    }
}

__device__ __forceinline__ void q_tile_issue(const bf16* q0, int lane, v4u (&t)[4]) {
    const int r = lane >> 3, ch = lane & 7;
#pragma unroll
    for (int it = 0; it < 4; ++it) t[it] = *(const GAS v4u*)(q0 + (size_t)(r + 8 * it) * INW + ch * 8);
}
__device__ __forceinline__ void q_tile_finish(const v4u (&t)[4], LAS unsigned char* st, int lane, v4u (&w)[4]) {
    const int r = lane >> 3, ch = lane & 7;
#pragma unroll
    for (int it = 0; it < 4; ++it) *(LAS v4u*)(st + (r + 8 * it) * 144 + ch * 16) = t[it];
    const int n = lane & 31, h = lane >> 5;
#pragma unroll
    for (int kk = 0; kk < 4; ++kk) w[kk] = *(const LAS v4u*)(st + n * 144 + (16 * kk + 8 * h) * 2);
}
__device__ __forceinline__ void load_q_tile(const bf16* q0, LAS unsigned char* st, int lane, v4u (&w)[4]) {
    const int r = lane >> 3, ch = lane & 7; v4u t[4];
#pragma unroll
    for (int it = 0; it < 4; ++it) t[it] = *(const GAS v4u*)(q0 + (size_t)(r + 8 * it) * INW + ch * 8);
#pragma unroll
    for (int it = 0; it < 4; ++it) *(LAS v4u*)(st + (r + 8 * it) * 144 + ch * 16) = t[it];
    const int n = lane & 31, h = lane >> 5;
#pragma unroll
    for (int kk = 0; kk < 4; ++kk) w[kk] = *(const LAS v4u*)(st + n * 144 + (16 * kk + 8 * h) * 2);
}
constexpr int SB_CHUNK = 2 * NWAVES;
__device__ __forceinline__ void attn_sb(Frame& F, const bf16* proj, const unsigned char* frag, bf16* Y, int task0) {
    const int lane = F.lane, n = lane & 31, h = lane >> 5;
    for (int task = task0 + F.wave; task < task0 + SB_CHUNK && task < BATCH * 8 * NKB; task += NWAVES) {
        const int qb = (NKB - 1) - (task >> 5), bh = task & 31, b = bh >> 3, hh = bh & 7;
        bf16x8 qf[4];
        { v4u qw[4]; load_q_tile(proj + (size_t)(b * SEQ + 32 * qb) * INW + C_SBQ + 64 * hh, F.lds + RING_OFF + F.wave * 8192, lane, qw); const float sc = 0.125f * LOG2E;
#pragma unroll
          for (int kk = 0; kk < 4; ++kk) { const v4u w = qw[kk]; v4u o;
              o.x = cvtpk(bflo(w.x) * sc, bfhi(w.x) * sc); o.y = cvtpk(bflo(w.y) * sc, bfhi(w.y) * sc); o.z = cvtpk(bflo(w.z) * sc, bfhi(w.z) * sc); o.w = cvtpk(bflo(w.w) * sc, bfhi(w.w) * sc);
              qf[kk] = as_bf16x8(o); } }
        f32x16 O0, O1;
#pragma unroll
        for (int i = 0; i < 16; ++i) { O0[i] = 0.f; O1[i] = 0.f; }
        float carry = 0.f;
        const GAS v4u* kbase = (const GAS v4u*)(frag + FR_SBK + (size_t)(bh * NKB) * 4096) + lane;
        const GAS v4u* vbase = (const GAS v4u*)(frag + FR_SBV + (size_t)(bh * NKB) * 4096) + lane;
        v4u kf[4], vf[4];
#pragma unroll
        for (int j = 0; j < 4; ++j) { kf[j] = kbase[(size_t)qb * 256 + j * 64]; vf[j] = vbase[(size_t)qb * 256 + j * 64]; }
        for (int kb = qb; kb >= 0; --kb) {
            v4u kn[4], vn[4];
            const int kbn = kb > 0 ? kb - 1 : 0;
#pragma unroll
            for (int j = 0; j < 4; ++j) { kn[j] = kbase[(size_t)kbn * 256 + j * 64]; vn[j] = vbase[(size_t)kbn * 256 + j * 64]; }
            f32x16 S;
#pragma unroll
            for (int i = 0; i < 16; ++i) S[i] = 0.f;
#pragma unroll
            for (int kk = 0; kk < 4; ++kk) S = MFMA32(as_bf16x8(kf[kk]), qf[kk], S);
            float lk[16], lb[16];
            const bool diag = (kb == qb);
#pragma unroll
            for (int i = 0; i < 16; ++i) { const float z = S[i]; const float L = __builtin_amdgcn_logf(1.f + __builtin_amdgcn_exp2f(-fabsf(z)));
                lk[i] = -(fmaxf(z, 0.f) + L); lb[i] = fminf(z, 0.f) - L;
                if (diag && ((i & 3) + 8 * (i >> 2) + 4 * h) >= n) { lk[i] = 0.f; lb[i] = -INFINITY; } }
            float rs[4], prs[4], T[4];
#pragma unroll
            for (int g = 0; g < 4; ++g) { rs[g] = (lk[4 * g] + lk[4 * g + 1]) + (lk[4 * g + 2] + lk[4 * g + 3]); prs[g] = __shfl_xor(rs[g], 32); T[g] = rs[g] + prs[g]; }
            float ST[4]; ST[3] = 0.f; ST[2] = T[3]; ST[1] = ST[2] + T[2]; ST[0] = ST[1] + T[1];
            float p[16];
#pragma unroll
            for (int g = 0; g < 4; ++g) { float ls = carry + ST[g] + (h == 0 ? prs[g] : 0.f);
#pragma unroll
                for (int j = 3; j >= 0; --j) { p[4 * g + j] = __builtin_amdgcn_exp2f(lb[4 * g + j] + ls); ls += lk[4 * g + j]; } }
            carry += ST[0] + T[0];
            v4u pw0, pw1;
            pw0.x = cvtpk(p[0], p[1]); pw0.y = cvtpk(p[2], p[3]); pw0.z = cvtpk(p[4], p[5]); pw0.w = cvtpk(p[6], p[7]);
            pw1.x = cvtpk(p[8], p[9]); pw1.y = cvtpk(p[10], p[11]); pw1.z = cvtpk(p[12], p[13]); pw1.w = cvtpk(p[14], p[15]);
            O0 = MFMA32(as_bf16x8(vf[0]), as_bf16x8(pw0), O0); O0 = MFMA32(as_bf16x8(vf[1]), as_bf16x8(pw1), O0);
            O1 = MFMA32(as_bf16x8(vf[2]), as_bf16x8(pw0), O1); O1 = MFMA32(as_bf16x8(vf[3]), as_bf16x8(pw1), O1);
            if (__builtin_amdgcn_ballot_w64(carry >= -40.f) == 0ull) break;
#pragma unroll
            for (int j = 0; j < 4; ++j) { kf[j] = kn[j]; vf[j] = vn[j]; }
        }
        { LAS unsigned char* st = F.lds + RING_OFF + F.wave * 8192;
#pragma unroll
          for (int g = 0; g < 4; ++g) {
              *(LAS v2u*)(st + n * 136 + (8 * g + 4 * h) * 2) = (v2u){cvtpk(O0[4 * g], O0[4 * g + 1]), cvtpk(O0[4 * g + 2], O0[4 * g + 3])};
              *(LAS v2u*)(st + n * 136 + (32 + 8 * g + 4 * h) * 2) = (v2u){cvtpk(O1[4 * g], O1[4 * g + 1]), cvtpk(O1[4 * g + 2], O1[4 * g + 3])}; }
          const LAS unsigned char* rd = st + (lane >> 3) * 136 + (lane & 7) * 16;
          bf16* yrow = Y + (size_t)(b * SEQ + 32 * qb + (lane >> 3)) * 1024 + 64 * hh + (lane & 7) * 8;
          v4u ov[4];
#pragma unroll
          for (int it = 0; it < 4; ++it) { const v2u a = *(const LAS v2u*)(rd + it * 8 * 136), c2 = *(const LAS v2u*)(rd + it * 8 * 136 + 8); ov[it] = (v4u){a.x, a.y, c2.x, c2.y}; }
#pragma unroll
          for (int it = 0; it < 4; ++it) *(GAS v4u*)(yrow + (size_t)it * 8 * 1024) = ov[it]; }
    }
}

constexpr int ATT_DONE_OFF = LDSCTL_OFF + 2048, ATT_Q_OFF = ATT_DONE_OFF + 128;
constexpr int ATT_RING = RING_OFF, ATT_SLOT = 16384, ATT_XO = RING_OFF + 65536;
static_assert(MOE_MAX_CHUNKS == 1, "the row-tile counters are indexed by the chunk-relative tile");
constexpr int CW_PANEL = 32768;
constexpr int CW_QUEUE = 9216;
__device__ __forceinline__ void glds16(const void* gsrc, unsigned lds_dst) { unsigned keep;
    asm volatile("s_mov_b32 %0, m0\n\ts_mov_b32 m0, %2\n\ts_nop 0\n\tglobal_load_lds_dwordx4 %1, off\n\ts_mov_b32 m0, %0" : "=&s"(keep) : "v"(gsrc), "s"(lds_dst) : "memory"); }
#define ATT_WAIT_BAR(N) asm volatile("s_waitcnt vmcnt(" #N ") lgkmcnt(0)\n\ts_barrier" ::: "memory")
__device__ __forceinline__ void attn_df(Frame& F, const bf16* proj, const unsigned char* frag, bf16* Y, const float* gq, const float* gk, const float* dl, const float* subg, float linit, int L) {
    const int w = F.wave, c = w & 1, qs = w >> 1;
    const float kmax = 8.f * wave_max(fabsf(gk[F.lane])) * 1.01f;
    const float lam = __expf(wave_sum(dl[F.lane] * dl[64 + F.lane])) - __expf(wave_sum(dl[128 + F.lane] * dl[192 + F.lane])) + linit;
    volatile LAS int* DONE = (volatile LAS int*)(F.lds + ATT_DONE_OFF);
    volatile LAS int* QW = (volatile LAS int*)(F.lds + ATT_Q_OFF);
    const unsigned lds0 = (unsigned)(size_t)(F.lds + ATT_RING);
    const int ncv = (L == 0) ? CVQ_ALL : 0;
    for (;;) {
        F.tid = cur_tid(); F.lane = F.tid & 63;
        const int lane = F.lane, n = lane & 31, h = lane >> 5;
        __syncthreads();
        if (F.tid == 0) QW[0] = (int)__hip_atomic_fetch_add((unsigned*)(F.ctl + CW_QUEUE + 64 * L), 1u, RLX_AGENT);
        if (lane == 0) { DONE[w] = 0; DONE[8 + w] = 0; }
        __syncthreads();
        int u = QW[0];
        constexpr int NDF = BATCH * 4 * (NKB / 4), NSB = BATCH * 8 * NKB / SB_CHUNK;
        if (u >= 256 && u < 256 + (NDF - 256) + ncv) { const int v = u - 256, T = (NDF - 256) + ncv, d0 = v * (NDF - 256) / T, d1 = (v + 1) * (NDF - 256) / T;
            if (d1 == d0) { convert_queue_unit(F, v - d0); continue; } u = 256 + d0; }
        else if (u >= NDF + ncv) u -= ncv;
        if (u >= NDF + NSB) break;
        if (u >= NDF) { attn_sb(F, proj, frag, Y, (u - NDF) * SB_CHUNK); continue; }
        const int qb4 = (NKB / 4 - 1) - (u >> 4), head = 3 - ((u & 15) >> 2), b = u & 3;
        const int qblk = 4 * qb4 + qs, kb_top = 4 * qb4 + 3;
        const float slope2 = exp2f(-2.f * (float)(head + 1)) * LOG2E, far_thr = 27.f + 2.f * (float)(head + 1);
        const unsigned char* psrc[2]; size_t pstep[2]; unsigned pdst[2];
#pragma unroll
        for (int i = 0; i < 2; ++i) { const int p = 2 * w + i;
            if (p < 8) { psrc[i] = frag + FR_DFK + (size_t)((b * 8 + 2 * head + (p >> 2)) * NKB) * 4096 + (size_t)(p & 3) * 1024 + lane * 16; pstep[i] = 4096; }
            else { psrc[i] = frag + FR_DFV + (size_t)((b * 4 + head) * NKB) * 8192 + (size_t)(p - 8) * 1024 + lane * 16; pstep[i] = 8192; }
            pdst[i] = lds0 + p * 1024; }
#define ATT_DMA(step) do { const int kbd_ = kb_top - (step); const int kbc_ = kbd_ > 0 ? kbd_ : 0; const unsigned so_ = (unsigned)(((step) & 7) * ATT_SLOT); \
        glds16(psrc[0] + (size_t)kbc_ * pstep[0], (unsigned)__builtin_amdgcn_readfirstlane(pdst[0] + so_)); glds16(psrc[1] + (size_t)kbc_ * pstep[1], (unsigned)__builtin_amdgcn_readfirstlane(pdst[1] + so_)); } while (0)
        v4u qt[4]; q_tile_issue(proj + (size_t)(b * SEQ + 32 * qblk) * INW + C_DFQ + (2 * head + c) * 64, lane, qt);
        ATT_DMA(0); ATT_DMA(1); ATT_DMA(2); ATT_DMA(3); ATT_DMA(4);
        bf16x8 qf[4]; float Bt;
        { v4u qw[4]; q_tile_finish(qt, F.lds + ATT_RING + 5 * ATT_SLOT + w * 6144, lane, qw);
          float x[32]; float ss = 0.f;
#pragma unroll
          for (int kk = 0; kk < 4; ++kk) { const v4u v = qw[kk];
              x[8 * kk + 0] = bflo(v.x); x[8 * kk + 1] = bfhi(v.x); x[8 * kk + 2] = bflo(v.y); x[8 * kk + 3] = bfhi(v.y); x[8 * kk + 4] = bflo(v.z); x[8 * kk + 5] = bfhi(v.z); x[8 * kk + 6] = bflo(v.w); x[8 * kk + 7] = bfhi(v.w); }
#pragma unroll
          for (int i = 0; i < 32; ++i) ss += x[i] * x[i];
          ss += __shfl_xor(ss, 32);
          const float rstd = rsqrtf(ss * (1.f / 64.f) + NORM_EPS) * (0.125f * LOG2E); float qn = 0.f;
#pragma unroll
          for (int kk = 0; kk < 4; ++kk) { const f32x4 g0 = *(const GAS f32x4*)(gq + 16 * kk + 8 * h), g1 = *(const GAS f32x4*)(gq + 16 * kk + 8 * h + 4);
              x[8 * kk + 0] *= rstd * g0.x; x[8 * kk + 1] *= rstd * g0.y; x[8 * kk + 2] *= rstd * g0.z; x[8 * kk + 3] *= rstd * g0.w;
              x[8 * kk + 4] *= rstd * g1.x; x[8 * kk + 5] *= rstd * g1.y; x[8 * kk + 6] *= rstd * g1.z; x[8 * kk + 7] *= rstd * g1.w;
              v4u o; o.x = cvtpk(x[8 * kk + 0], x[8 * kk + 1]); o.y = cvtpk(x[8 * kk + 2], x[8 * kk + 3]); o.z = cvtpk(x[8 * kk + 4], x[8 * kk + 5]); o.w = cvtpk(x[8 * kk + 6], x[8 * kk + 7]);
              qf[kk] = as_bf16x8(o); }
#pragma unroll
          for (int i = 0; i < 32; ++i) qn += x[i] * x[i];
          qn += __shfl_xor(qn, 32);
          Bt = sqrtf(qn) * kmax * 1.01f; }
        f32x16 O[4];
#pragma unroll
        for (int d = 0; d < 4; ++d)
#pragma unroll
            for (int i = 0; i < 16; ++i) O[d][i] = 0.f;
        const float tq = (float)(32 * qblk + n);
        const float cb0 = slope2 * ((float)(4 * h) - tq) - Bt;
#define ATT_BIAS(S_, kb_) do { const float kt_ = cb0 + slope2 * (float)(32 * (kb_)); _Pragma("unroll") for (int i_ = 0; i_ < 16; ++i_) S_[i_] = __builtin_fmaf(slope2, (float)((i_ & 3) + 8 * (i_ >> 2)), kt_); } while (0)
#define ATT_QK(S_, slotidx_, kb_) do { const LAS v4u* sk_ = (const LAS v4u*)(F.lds + ATT_RING + (slotidx_) * ATT_SLOT) + lane; \
        const v4u k0_ = sk_[(4 * c + 0) * 64], k1_ = sk_[(4 * c + 1) * 64], k2_ = sk_[(4 * c + 2) * 64], k3_ = sk_[(4 * c + 3) * 64]; ATT_BIAS(S_, kb_); \
        S_ = MFMA32(as_bf16x8(k0_), qf[0], S_); S_ = MFMA32(as_bf16x8(k1_), qf[1], S_); S_ = MFMA32(as_bf16x8(k2_), qf[2], S_); S_ = MFMA32(as_bf16x8(k3_), qf[3], S_); } while (0)
        ATT_WAIT_BAR(8);
        f32x16 SA, SB; float ls = 0.f;
#pragma unroll
        for (int i = 0; i < 16; ++i) { SA[i] = 0.f; SB[i] = 0.f; }
        if (kb_top <= qblk) ATT_QK(SA, 0, kb_top);
#define ATT_SOFTPV(SCUR, DIAG_, VF_) do { \
                const LAS v4u* sl = (const LAS v4u*)(F.lds + ATT_RING + (st & 7) * ATT_SLOT) + lane; (void)sl; \
                float p[16]; \
                _Pragma("unroll") for (int i = 0; i < 16; ++i) p[i] = __builtin_amdgcn_exp2f(SCUR[i]); \
                if (DIAG_) { int dn_ = n - 4 * h; asm volatile("" : "+v"(dn_)); _Pragma("unroll") for (int i = 0; i < 16; ++i) if (((i & 3) + 8 * (i >> 2)) > dn_) p[i] = 0.f; }     \
                v4u pw0, pw1; \
                pw0.x = cvtpk(p[0], p[1]); pw0.y = cvtpk(p[2], p[3]); pw0.z = cvtpk(p[4], p[5]); pw0.w = cvtpk(p[6], p[7]); \
                pw1.x = cvtpk(p[8], p[9]); pw1.y = cvtpk(p[10], p[11]); pw1.z = cvtpk(p[12], p[13]); pw1.w = cvtpk(p[14], p[15]); \
                ls += (((p[0] + p[1]) + (p[2] + p[3])) + ((p[4] + p[5]) + (p[6] + p[7]))) + (((p[8] + p[9]) + (p[10] + p[11])) + ((p[12] + p[13]) + (p[14] + p[15]))); \
                _Pragma("unroll") for (int dd = 0; dd < 4; ++dd) { O[dd] = MFMA32(as_bf16x8(VF_(2 * dd)), as_bf16x8(pw0), O[dd]); O[dd] = MFMA32(as_bf16x8(VF_(2 * dd + 1)), as_bf16x8(pw1), O[dd]); } } while (0)
#define ATT_VLDS(j_) sl[(8 + (j_)) * 64]
#define ATT_VREG(j_) vf_[j_]
#define ATT_STEP_G(st_, SCUR, SNEXT) do { const int st = (st_); const int kb = kb_top - st; \
            ATT_WAIT_BAR(6);                                              \
            ATT_DMA(st + 5); \
            const bool act = (kb <= qblk), actn = (kb >= 1) && (kb - 1 <= qblk); \
            if (actn) ATT_QK(SNEXT, (st + 1) & 7, kb - 1); \
            if (act) ATT_SOFTPV(SCUR, kb == qblk, ATT_VLDS); \
        } while (0)
#define ATT_SEG_BAR() do { __builtin_amdgcn_sched_barrier(0); ATT_WAIT_BAR(4); __builtin_amdgcn_sched_barrier(0); } while (0)
#define ATT_PIN4(a_) asm volatile("" : "+v"(a_[0]), "+v"(a_[1]), "+v"(a_[2]), "+v"(a_[3]))
#define ATT_STEP_M(st_, SCUR, SNEXT) do { const int st = (st_); const int kb = kb_top - st; \
            ATT_SEG_BAR(); \
              \
            v4u vf_[8]; { const LAS v4u* sv_ = (const LAS v4u*)(F.lds + ATT_RING + (st & 7) * ATT_SLOT) + lane; _Pragma("unroll") for (int j_ = 0; j_ < 8; ++j_) vf_[j_] = sv_[(8 + j_) * 64]; } \
            v4u kfm_[4]; { const LAS v4u* sk_ = (const LAS v4u*)(F.lds + ATT_RING + ((st + 1) & 7) * ATT_SLOT) + lane; _Pragma("unroll") for (int j_ = 0; j_ < 4; ++j_) kfm_[j_] = sk_[(4 * c + j_) * 64]; } \
            float p[16]; \
            _Pragma("unroll") for (int i = 0; i < 16; ++i) p[i] = __builtin_amdgcn_exp2f(SCUR[i]); \
            v4u pw_[2]; \
            pw_[0].x = cvtpk(p[0], p[1]); pw_[0].y = cvtpk(p[2], p[3]); pw_[0].z = cvtpk(p[4], p[5]); pw_[0].w = cvtpk(p[6], p[7]); \
            pw_[1].x = cvtpk(p[8], p[9]); pw_[1].y = cvtpk(p[10], p[11]); pw_[1].z = cvtpk(p[12], p[13]); pw_[1].w = cvtpk(p[14], p[15]); \
            ls += (((p[0] + p[1]) + (p[2] + p[3])) + ((p[4] + p[5]) + (p[6] + p[7]))) + (((p[8] + p[9]) + (p[10] + p[11])) + ((p[12] + p[13]) + (p[14] + p[15]))); \
            ATT_SEG_BAR(); \
              \
              \
            asm volatile("" : "+v"(pw_[0]), "+v"(pw_[1])); ATT_PIN4(kfm_); \
            ATT_BIAS(SNEXT, kb - 1); \
              \
            SNEXT = MFMA32(as_bf16x8(kfm_[0]), qf[0], SNEXT); SNEXT = MFMA32(as_bf16x8(kfm_[1]), qf[1], SNEXT); SNEXT = MFMA32(as_bf16x8(kfm_[2]), qf[2], SNEXT); SNEXT = MFMA32(as_bf16x8(kfm_[3]), qf[3], SNEXT); \
            ATT_DMA(st + 5); \
            _Pragma("unroll") for (int dd = 0; dd < 4; ++dd) { O[dd] = MFMA32(as_bf16x8(vf_[2 * dd]), as_bf16x8(pw_[0]), O[dd]); O[dd] = MFMA32(as_bf16x8(vf_[2 * dd + 1]), as_bf16x8(pw_[1]), O[dd]); } \
            asm volatile("" : "+v"(SNEXT), "+v"(ls)); ATT_PIN4(O); \
        } while (0)
        ATT_STEP_G(0, SA, SB); ATT_STEP_G(1, SB, SA); ATT_STEP_G(2, SA, SB); ATT_STEP_G(3, SB, SA);
        int st_end;
        { const float lmin = -wave_max(-(ls + __shfl_xor(ls, 32)));
          const float need = (far_thr - __builtin_amdgcn_logf(lmin)) / slope2;
          const float nf = fminf(fmaxf(ceilf((need - 1.f) * (1.f / 32.f)), 0.f), 1048576.f);
          if (lane == 0) DONE[w] = (3 - qs) + (int)nf;
          asm volatile("s_waitcnt lgkmcnt(0)\n\ts_barrier" ::: "memory");
          const LAS v4u* dn_ = (const LAS v4u*)(F.lds + ATT_DONE_OFF); const v4u d0_ = dn_[0], d1_ = dn_[1];
          const unsigned mx_ = max(max(max(d0_.x, d0_.y), max(d0_.z, d0_.w)), max(max(d1_.x, d1_.y), max(d1_.z, d1_.w)));
          const int sl_ = (int)__builtin_amdgcn_readfirstlane(mx_); st_end = sl_ < kb_top ? sl_ : kb_top; }
        { const int m_end = st_end < kb_top - 2 ? st_end : kb_top - 2; int st2 = 4;
          if (w >= 4) ATT_SEG_BAR();
          for (; st2 + 1 <= m_end; st2 += 2) { ATT_STEP_M(st2, SA, SB); ATT_STEP_M(st2 + 1, SB, SA); }
          if (st2 <= m_end) ATT_STEP_M(st2, SA, SB);
          if (w < 4) ATT_SEG_BAR();
        }
        if (kb_top >= 7 && st_end >= kb_top - 1) { ATT_STEP_G(kb_top - 1, SA, SB); ATT_STEP_G(kb_top, SB, SA); }
#undef ATT_STEP_G
#undef ATT_STEP_M
#undef ATT_SEG_BAR
#undef ATT_PIN4
#undef ATT_SOFTPV
#undef ATT_VLDS
#undef ATT_VREG
#undef ATT_QK
#undef ATT_BIAS
        float l = ls + __shfl_xor(ls, 32);
        asm volatile("s_waitcnt vmcnt(0)" ::: "memory");
        __syncthreads();
        LAS v4u* XO = (LAS v4u*)(F.lds + ATT_XO) + (qs * 16) * 64 + lane;
        if (c == 1) { const float a1 = -lam / l;
#pragma unroll
            for (int d = 0; d < 4; ++d)
#pragma unroll
                for (int g = 0; g < 4; ++g) XO[(4 * d + g) * 64] = (v4u){__float_as_uint(O[d][4 * g] * a1), __float_as_uint(O[d][4 * g + 1] * a1), __float_as_uint(O[d][4 * g + 2] * a1), __float_as_uint(O[d][4 * g + 3] * a1)}; }
        __syncthreads();
        if (c == 0) { const float a0 = 1.f / l; float ssq = 0.f;
#pragma unroll
            for (int d = 0; d < 4; ++d)
#pragma unroll
                for (int g = 0; g < 4; ++g) { const v4u x1 = XO[(4 * d + g) * 64];
                    O[d][4 * g] = O[d][4 * g] * a0 + __uint_as_float(x1.x); O[d][4 * g + 1] = O[d][4 * g + 1] * a0 + __uint_as_float(x1.y);
                    O[d][4 * g + 2] = O[d][4 * g + 2] * a0 + __uint_as_float(x1.z); O[d][4 * g + 3] = O[d][4 * g + 3] * a0 + __uint_as_float(x1.w);
                    ssq += (O[d][4 * g] * O[d][4 * g] + O[d][4 * g + 1] * O[d][4 * g + 1]) + (O[d][4 * g + 2] * O[d][4 * g + 2] + O[d][4 * g + 3] * O[d][4 * g + 3]); }
            ssq += __shfl_xor(ssq, 32);
            const float rn = rsqrtf(ssq * (1.f / 128.f) + NORM_EPS) * (1.f - linit);
            f32x4 ggv[4][4];
#pragma unroll
            for (int d = 0; d < 4; ++d)
#pragma unroll
                for (int g = 0; g < 4; ++g) ggv[d][g] = *(const GAS f32x4*)(subg + 32 * d + 8 * g + 4 * h);
            LAS unsigned char* st = (LAS unsigned char*)(F.lds + ATT_XO) + qs * 16384;
#pragma unroll
            for (int d = 0; d < 4; ++d)
#pragma unroll
                for (int g = 0; g < 4; ++g) { const f32x4 gg = ggv[d][g];
                    *(LAS v2u*)(st + n * 264 + (32 * d + 8 * g + 4 * h) * 2) = (v2u){cvtpk(O[d][4 * g] * rn * gg.x, O[d][4 * g + 1] * rn * gg.y), cvtpk(O[d][4 * g + 2] * rn * gg.z, O[d][4 * g + 3] * rn * gg.w)}; }
            const LAS unsigned char* rd = st + (lane >> 4) * 264 + (lane & 15) * 16;
            bf16* yrow = Y + (size_t)(b * SEQ + 32 * qblk + (lane >> 4)) * 1024 + 512 + 128 * head + (lane & 15) * 8;
            v4u ov[8];
#pragma unroll
            for (int it = 0; it < 8; ++it) { const v2u a = *(const LAS v2u*)(rd + it * 4 * 264), c2 = *(const LAS v2u*)(rd + it * 4 * 264 + 8); ov[it] = (v4u){a.x, a.y, c2.x, c2.y}; }
#pragma unroll
            for (int it = 0; it < 8; ++it) *(GAS v4u*)(yrow + (size_t)it * 4 * 1024) = ov[it]; }
    }
#undef ATT_DMA
    __syncthreads();
}

#ifndef N_LAUNCH_MODE
#define N_LAUNCH_MODE 1
#endif
struct Args { const float* in[19]; float* out; unsigned char* ws; int ph_lo, ph_hi; };
constexpr int PH_L0 = 2, PH_L1 = 13, PH_MOE = PH_L1 + 9, PH_COMB = PH_MOE + 2 * MOE_MAX_CHUNKS, NPHASES = PH_COMB + 1;

__global__ void __launch_bounds__(NWAVES * 64, 2) fwd_kernel(Args args) {
    extern __shared__ __attribute__((aligned(16))) unsigned char lds[];
    Frame F;
    F.lds = (LAS unsigned char*)lds;
    F.MISC = (volatile LAS unsigned*)(F.lds + MISC_OFF);
    F.tid = threadIdx.x; F.lane = F.tid & 63; F.wave = __builtin_amdgcn_readfirstlane(F.tid >> 6);
    F.G = gridDim.x; { const int bx = blockIdx.x; F.vcu = (F.G % 8 == 0) ? (bx % 8) * (F.G / 8) + bx / 8 : bx; }
    F.ws = args.ws; F.ctl = (gu32*)(args.ws + WS_CTL); F.in = (const __attribute__((address_space(4))) Frame::cfptr_t*)(unsigned long long)__builtin_amdgcn_kernarg_segment_ptr(); F.out = args.out;
    unsigned char* ws = args.ws;
    for (int u = F.tid; u < (LDS_BYTES - LDSCTL_OFF) / 4; u += NWAVES * 64) ((LAS unsigned*)(F.lds + LDSCTL_OFF))[u] = 0u;
    __syncthreads();
    const int lo = args.ph_lo, hi = args.ph_hi;
    XcdBarrier bar; bar.bar = (unsigned*)(F.ctl + CW_BAR); bar.x = 0; bar.st = nullptr;
    if (hi - lo > 1) bar = xcd_barrier_post((unsigned*)(F.ctl + CW_BAR), F.MISC + 8);
#define IN(k) (lo <= (k) && (k) < hi)
#define SEAM(k) do { if (lo <= (k) && (k) + 1 < hi) xcd_barrier(bar); } while (0)
#define REFRESH() do { F.tid = cur_tid(); F.lane = F.tid & 63; { unsigned long long kp_ = (unsigned long long)__builtin_amdgcn_kernarg_segment_ptr(); asm volatile("" : "+s"(kp_)); F.in = (const __attribute__((address_space(4))) Frame::cfptr_t*)kp_; } } while (0)
    bf16* const Hb = (bf16*)(ws + WS_H); bf16* const Yb = (bf16*)(ws + WS_Y); bf16* const PROJ = (bf16*)(ws + WS_PROJ);
    bf16* const GATES = (bf16*)(ws + WS_GATES); bf16* const MERGED = (bf16*)(ws + WS_MERGED); bf16* const HID = (bf16*)(ws + WS_HID);
    const int bx = (int)blockIdx.x; __builtin_assume(bx >= 0 && bx < 256);

    unsigned char* const H8 = ws + WS_H; float* const SA = (float*)(ws + WS_SA); float* const PMAX = (float*)(ws + WS_PMAX); const float* const SWC = (const float*)(ws + WS_SWC);
    if (IN(0)) { REFRESH(); if (F.vcu < INW / 32) convert_i8_colblock(F, F.in[2], INW, ws + WS_WT + WT_WIN, 0, (float*)(ws + WS_SWC) + wq_coff(0), F.vcu); norm_rows_i8<false>(F, F.in[0], F.in[1], H8, SA); }
    SEAM(0);

    for (int L = 0; L < 2; ++L) {
        const int base = L ? PH_L1 : PH_L0;
        const unsigned char* wt = ws + WS_WT + (size_t)L * WT_LAYER;
        if (IN(base + 0)) { REFRESH();
            { pg8::Gemm g{Hb, (const bf16*)(wt + WT_WIN), D / 2, D / 2}; pg8::QkOrder S; S.init(M, 2048, F.G, bx);
              EpiQkStore E{PROJ, INW, SA, SWC + wq_coff(2 * L), ws + WS_FRAG + FR_DFK, F.in[4] + L * 64, (LAS float*)(F.lds + LDSCTL_OFF + 4096), ws + WS_FRAG + FR_SBK};
              pg8::gemm_phase<EpiQkStore, pg8::QkOrder, true, true, 2>(F.lds + RING_OFF, g, S, E); }
            asm volatile("s_waitcnt vmcnt(0)" ::: "memory"); __syncthreads();
            { pg8::Gemm g{(const bf16*)(wt + WT_WIN), Hb, D / 2, D / 2}; pg8::VtOrder S; S.init(1024, M, F.G, bx); S.rsb = C_SBV; S.rdf = C_DFV;
              EpiVtFrag E{ws + WS_FRAG, SA, SWC + wq_coff(2 * L) + C_SBV, SWC + wq_coff(2 * L) + C_DFV};
              pg8::gemm_phase<EpiVtFrag, pg8::VtOrder, true, true, 2>(F.lds + RING_OFF, g, S, E); }
        }
        SEAM(base + 0);
        if (IN(base + 2)) { REFRESH();
            attn_df(F, PROJ, ws + WS_FRAG, Yb, F.in[3] + L * 64, F.in[4] + L * 64, F.in[5] + L * 256, F.in[6] + L * 128, 0.8f - 0.6f * __expf(-0.3f * (float)L), L); }
        SEAM(base + 2);
        if (IN(base + 3)) { REFRESH();
            pg8::Gemm g{Hb, (const bf16*)(wt + WT_WG), D / 2, D / 2}; pg8::GatesOrder S; S.init(M, D, F.G, bx);
            pg8::EpiStoreBf16Q<2> E{GATES, GATEW, F.in[8] + L * GATEW, SA, SWC + wq_coff(2 * L + 1)};
            pg8::gemm_phase<pg8::EpiStoreBf16Q<2>, pg8::GatesOrder, true, true, 2>(F.lds + RING_OFF, g, S, E);
        }
        if (lo <= base + 3 && base + 4 < hi) { asm volatile("s_waitcnt vmcnt(0)" ::: "memory"); __syncthreads(); }
        if (IN(base + 4)) { REFRESH();
            pg8::Gemm g{Yb, (const bf16*)(wt + WT_WSB), 1024, 512}; pg8::StaticOrder S; S.init(M, D, F.G, bx);
            pg8::EpiGateMul<false> E{MERGED, D, GATES, GATEW};
            pg8::gemm_phase<pg8::EpiGateMul<false>, pg8::StaticOrder, true, true>(F.lds + RING_OFF, g, S, E);
        }
        if (lo <= base + 4 && base + 5 < hi) { asm volatile("s_waitcnt vmcnt(0)" ::: "memory"); __syncthreads(); }
        if (IN(base + 5)) { REFRESH();
            pg8::Gemm g{Yb + 512, (const bf16*)(wt + WT_WDF), 1024, 512}; pg8::StaticOrder S; S.init(M, D, F.G, bx);
            pg8::EpiGateMul<true> E{MERGED, D, GATES + 1024, GATEW};
            pg8::gemm_phase<pg8::EpiGateMul<true>, pg8::StaticOrder, true, true>(F.lds + RING_OFF, g, S, E);
        }
        SEAM(base + 5);
        if (IN(base + 6)) { REFRESH();
            pg8::Gemm g{MERGED, (const bf16*)(wt + WT_WOUT), D, D}; pg8::StaticOrder S; S.init(M, D, F.G, bx);
            pg8::EpiResBf E{L ? nullptr : F.in[0], D, (bf16*)F.out, XLD};
            pg8::gemm_phase<pg8::EpiResBf, pg8::StaticOrder, true, true>(F.lds + RING_OFF, g, S, E);
        }
        SEAM(base + 6);
        if (L == 0) {
            if (IN(base + 7)) { REFRESH(); norm_rows_i8<true>(F, F.out, F.in[12], H8, SA); }
            SEAM(base + 7);
            if (IN(base + 8)) { REFRESH();
                pg8::Gemm g{Hb, (const bf16*)(ws + WS_WGU), D / 2, D / 2}; pg8::StaticOrder S; S.init(M, 2 * DFF, F.G, bx);
                pg8::EpiSwigluQ8 E{HID, DFF, SA, SWC + wq_coff(4), SWC + wq_coff(4) + DFF, (LAS float*)(F.lds + LDSCTL_OFF + 12288)};
                pg8::gemm_phase<pg8::EpiSwigluQ8, pg8::StaticOrder, true, true, 2>(F.lds + RING_OFF, g, S, E);
            }
            SEAM(base + 8);
            if (IN(base + 9)) { REFRESH();
                pg8::Gemm g{HID, (const bf16*)(ws + WS_WDOWN), DFF / 2, DFF / 2}; pg8::StaticOrder S; S.init(M, D, F.G, bx);
                pg8::EpiResBf8 E{nullptr, D, (bf16*)F.out, XLD, 1.f / SC_W2};
                pg8::gemm_phase<pg8::EpiResBf8, pg8::StaticOrder, true, true, 1>(F.lds + RING_OFF, g, S, E);
            }
            SEAM(base + 9);
            if (IN(base + 10)) { REFRESH(); norm_rows_i8<true>(F, F.out, F.in[1] + D, H8, SA); }
            SEAM(base + 10);
        } else {
            int* const LTOK = (int*)(ws + WS_LTOK); float* const LW = (float*)(ws + WS_LW); int* const TPOS = (int*)(ws + WS_STOK); float* const SW = (float*)(ws + WS_SW);
            bf16* const XS = (bf16*)(ws + WS_XS); bf16* const HIDC = (bf16*)(ws + WS_HIDC); bf16* const YS = (bf16*)(ws + WS_YS);
            if (IN(base + 7)) { REFRESH(); norm_route_rows(F, (const bf16*)F.out, F.in[12] + D, Hb, F.in[15], LTOK, LW, TPOS); }
            SEAM(base + 7);
            if (hi > base + 8) moe_plan(F);
            const LAS int* PLAN = (const LAS int*)(F.lds + PLAN_OFF);
            if (IN(base + 8)) { REFRESH(); moe_gather(F, Hb, XS, LTOK, LW, SW); }
            SEAM(base + 8);
            const int ntile = PLAN[17];
            for (int c = 0; c < MOE_MAX_CHUNKS; ++c) {
                const int tile0 = c * MOE_CHUNK_TILES, nt = (ntile - tile0) < MOE_CHUNK_TILES ? (ntile - tile0) : MOE_CHUNK_TILES;
                if (nt <= 0) break;
                int Gl = F.G; asm volatile("" : "+s"(Gl));
                const int n1 = nt * (2 * DFE / 256), n2 = nt * (D / 256), q2 = n2 / Gl, nH = n2 - q2 * Gl;
                int h1 = 0;
                if (nH > 0) { h1 = ((4 * n1 + 15 * nH) / Gl - 13) >> 2; h1 = h1 < 0 ? 0 : h1; if (h1 * nH > n1) h1 = n1 / nH; }
                unsigned* const PANEL = (unsigned*)(F.ctl + CW_PANEL);
                if (IN(PH_MOE + 2 * c)) { REFRESH();
                    pg8::MoeDeal<false, true> S1; S1.G = F.G; S1.c = bx; S1.tile0 = tile0; S1.nM = nt; S1.nN = 2 * DFE / 256; S1.nwg = n1; S1.a_tile_off = tile0; S1.b_exp_bytes = MOE13_EXP;
                    S1.nH = nH; S1.hk = h1; S1.pub = PANEL; S1.prev_pm = -1;
#pragma unroll
                    for (int j = 0; j < 9; ++j) S1.ts[j] = PLAN[j];
                    pg8::Gemm g{XS, (const bf16*)(ws + WS_MOE13), D / 2, D / 2};
                    pg8::EpiSwiglu8 E{(unsigned char*)HIDC, DFE, 1.f / SC_W13};
                    pg8::gemm_phase<pg8::EpiSwiglu8, pg8::MoeDeal<false, true>, true, true, true>(F.lds + RING_OFF, g, S1, E);
                    S1.publish_last();
                }
                if (IN(PH_MOE + 2 * c + 1)) { REFRESH();
                    pg8::MoeDeal<true, false> S2; S2.G = F.G; S2.c = bx; S2.tile0 = tile0; S2.nM = nt; S2.nN = D / 256; S2.nwg = n2; S2.a_tile_off = 0; S2.b_exp_bytes = MOE2_EXP;
                    S2.nH = nH; S2.hk = q2 + 1; S2.pub = nullptr; S2.prev_pm = -1;
#pragma unroll
                    for (int j = 0; j < 9; ++j) S2.ts[j] = PLAN[j];
                    if (F.wave == 0) {
                        int spins = 0;
                        for (int i = 0; spins < 400000; ++i) { pg8::Unit u; if (!S2.next(i, u)) break;
                            while (spins < 400000 && (unsigned)__builtin_amdgcn_readfirstlane(__hip_atomic_load(PANEL + 64 * u.pm, __ATOMIC_RELAXED, __HIP_MEMORY_SCOPE_AGENT)) < (unsigned)((2 * DFE / 256) * NWAVES)) {
                                ++spins; __builtin_amdgcn_s_sleep(2); } }
                        __builtin_amdgcn_fence(__ATOMIC_ACQUIRE, "agent");
                        asm volatile("s_waitcnt vmcnt(0)" ::: "memory"); }
                    __syncthreads();
                    pg8::Gemm g{HIDC, (const bf16*)(ws + WS_MOE2), DFE / 2, DFE / 2};
                    pg8::EpiMoeStore E{YS, D, SW, tile0 * 256, 1.f / SC_W2};
                    pg8::gemm_phase<pg8::EpiMoeStore, pg8::MoeDeal<true, false>, true, true, true>(F.lds + RING_OFF, g, S2, E);
                }
                SEAM(PH_MOE + 2 * c + 1);
            }
            if (IN(PH_COMB)) { REFRESH(); moe_combine(F, F.out, YS, TPOS); }
        }
    }
#undef IN
#undef SEAM
#undef REFRESH
}

extern "C" void kernel_launch(void* const* d_in, const int* in_sizes, int n_in, void* d_out, int out_size, void* d_ws, size_t ws_size, hipStream_t stream) {
    static int grid = 0;
    if (grid == 0) {
        if (n_in != 19 || in_sizes[0] != M * D || out_size != M * D || ws_size < WS_END) { fprintf(stderr, "kernel_launch: unexpected shapes (n_in %d, in0 %d, out %d, ws %zu < %zu); nothing launched\n", n_in, n_in > 0 ? in_sizes[0] : -1, out_size, ws_size, (size_t)WS_END); grid = -1; return; }
        int dev = 0, cus = 0, per_cu = 0;
        if (hipGetDevice(&dev) != hipSuccess || hipDeviceGetAttribute(&cus, hipDeviceAttributeMultiprocessorCount, dev) != hipSuccess) { grid = -1; return; }
        if (hipFuncSetAttribute((const void*)fwd_kernel, hipFuncAttributeMaxDynamicSharedMemorySize, LDS_BYTES) != hipSuccess) { fprintf(stderr, "kernel_launch: hipFuncSetAttribute failed\n"); grid = -1; return; }
        if (hipOccupancyMaxActiveBlocksPerMultiprocessor(&per_cu, (const void*)fwd_kernel, NWAVES * 64, LDS_BYTES) != hipSuccess || per_cu < 1)
            fprintf(stderr, "kernel_launch: note: occupancy query reports %d workgroups per CU\n", per_cu);
        (void)hipGetLastError();
        grid = cus < 256 ? (cus / 8) * 8 : 256;
        if (grid < 32) { grid = -1; return; }
    }
    if (grid < 0) return;
    if (hipMemsetAsync((char*)d_ws + WS_CTL, 0, CTL_ZERO_BYTES, stream) != hipSuccess) return;
    Args a{};
    for (int i = 0; i < 19; ++i) a.in[i] = (const float*)d_in[i];
    a.out = (float*)d_out; a.ws = (unsigned char*)d_ws;
#if N_LAUNCH_MODE == 1
    a.ph_lo = 0; a.ph_hi = NPHASES;
    hipLaunchKernelGGL(fwd_kernel, dim3(grid), dim3(NWAVES * 64), LDS_BYTES, stream, a);
#else
    for (int p = 0; p < NPHASES; ++p) { a.ph_lo = p; a.ph_hi = p + 1; hipLaunchKernelGGL(fwd_kernel, dim3(grid), dim3(NWAVES * 64), LDS_BYTES, stream, a); }
#endif
}
```
